# Optimizing an MI355X kernel written in HIP

```python
import jax
import jax.numpy as jnp
from jax import lax
import numpy as np


D_MODEL = 1024
BATCH = 2
SEQ = 8192
DEPTH = 2

N_A_LAYERS = DEPTH // 2
N_B_LAYERS = DEPTH - N_A_LAYERS
Q_BLOCK = 128
NEG_INF = -1e30
NORM_EPS = 1e-6

NSA_HEADS = 16
NSA_GROUPS = 4
NSA_HPG = NSA_HEADS // NSA_GROUPS
NSA_DH = 64
CMP_BLOCK = 32
CMP_STRIDE = 16
CMP_HIDDEN = 256
SLC_BLOCK = 64
SLC_TOP = 16
WINDOW = 512
FORCE_SCORE = 1e4
NSA_IN_WIDTH = NSA_HEADS * NSA_DH + 6 * NSA_GROUPS * NSA_DH + 3 * NSA_HEADS

MLA_HEADS = 8
QK_NOPE = 128
QK_ROPE = 64
MLA_V = 128
Q_LORA = 384
KV_LORA = 256
ROPE_THETA = 10000.0

FFN_HIDDEN = -(-8 * D_MODEL // (3 * 256)) * 256

kernel_name = 'yoco_nsa_mla_hybrid'


def rms_norm(x, g):
    xf = x.astype(jnp.float32)
    y = xf * lax.rsqrt(jnp.mean(xf * xf, axis=-1, keepdims=True) + NORM_EPS)
    return (y * g.astype(jnp.float32)).astype(x.dtype)


def masked_softmax(s, mask):
    p = jax.nn.softmax(jnp.where(mask, s, NEG_INF), axis=-1)
    return jnp.where(mask, p, 0.0)


def alibi_slopes(n):
    return 2.0 ** (-8.0 * jnp.arange(1, n + 1, dtype=jnp.float32) / n)


def rope_tables(T):
    inv = ROPE_THETA ** (-jnp.arange(0, QK_ROPE, 2, dtype=jnp.float32) / QK_ROPE)
    ang = jnp.arange(T, dtype=jnp.float32)[:, None] * inv[None, :]
    return jnp.cos(ang), jnp.sin(ang)


def apply_rope(x, cos, sin):
    c = cos[None, :, None, :].astype(x.dtype)
    s = sin[None, :, None, :].astype(x.dtype)
    x1, x2 = jnp.split(x, 2, axis=-1)
    return jnp.concatenate([x1 * c - x2 * s, x1 * s + x2 * c], axis=-1)


def swiglu(h, w_gate_up, w_down):
    gate, up = jnp.split(h @ w_gate_up, 2, axis=-1)
    return (jax.nn.silu(gate) * up) @ w_down


_gather_bg = jax.vmap(jax.vmap(lambda src, idx: src[idx]))


def nsa_mixer(h, w_in, q_norm, kcmp_norm, kslc_norm, kwin_norm, pos_k, pos_v,
              k_w1, k_b1, k_w2, v_w1, v_b1, v_w2, w_out):
    B, T, _ = h.shape
    G, HG, DH = NSA_GROUPS, NSA_HPG, NSA_DH
    f32 = jnp.float32
    qw, kvw = NSA_HEADS * DH, G * DH
    cuts = [qw + i * kvw for i in range(7)]
    parts = jnp.split(h @ w_in, cuts, axis=-1)
    q = rms_norm(parts[0].reshape(B, T, G, HG, DH), q_norm)
    kc, vc, ksl, vsl, kw, vw = [a.reshape(B, T, G, DH) for a in parts[1:7]]
    gates = jax.nn.sigmoid(parts[7].astype(f32)).astype(h.dtype).reshape(B, T, G, HG, 3)

    n_cmp = (T - CMP_BLOCK) // CMP_STRIDE + 1
    cmp_j = jnp.arange(n_cmp)
    cmp_idx = cmp_j[:, None] * CMP_STRIDE + jnp.arange(CMP_BLOCK)[None, :]

    def compress(a, pe, w1, b1, w2):
        blk = a[:, cmp_idx] + pe[:, None, :].astype(a.dtype)
        blk = jnp.swapaxes(blk, 2, 3).reshape(B, n_cmp, G, CMP_BLOCK * DH)
        return jax.nn.gelu(blk @ w1 + b1) @ w2

    k_cmp = rms_norm(compress(kc, pos_k, k_w1, k_b1, k_w2), kcmp_norm)
    v_cmp = compress(vc, pos_v, v_w1, v_b1, v_w2)
    k_sel_src = jnp.swapaxes(rms_norm(ksl, kslc_norm), 1, 2)
    v_sel_src = jnp.swapaxes(vsl, 1, 2)
    pad = ((0, 0), (WINDOW, 0), (0, 0), (0, 0))
    kw_pad = jnp.pad(rms_norm(kw, kwin_norm), pad)
    vw_pad = jnp.pad(vw, pad)

    slopes = alibi_slopes(NSA_HEADS).reshape(G, HG)[:, :, None, None]
    scale = DH ** -0.5
    n_slc = T // SLC_BLOCK
    n_top = min(SLC_TOP, n_slc)
    n_sel = n_top * SLC_BLOCK
    cmp_end = cmp_j * CMP_STRIDE + CMP_BLOCK - 1
    cmp_mid = (cmp_j * CMP_STRIDE).astype(f32) + 0.5 * (CMP_BLOCK - 1)
    slc_i = jnp.arange(n_slc)
    overlap = ((cmp_j[:, None] * CMP_STRIDE <= slc_i[None, :] * SLC_BLOCK + SLC_BLOCK - 1)
               & (cmp_end[:, None] >= slc_i[None, :] * SLC_BLOCK)).astype(f32)
    win_off = jnp.arange(WINDOW + Q_BLOCK)
    in_blk = jnp.arange(SLC_BLOCK)

    def block(s0):
        t = s0 + jnp.arange(Q_BLOCK)
        tf = t.astype(f32)
        qb = lax.dynamic_slice_in_dim(q, s0, Q_BLOCK, axis=1)
        gb = lax.dynamic_slice_in_dim(gates, s0, Q_BLOCK, axis=1)
        s_c = (jnp.einsum('bqghd,bjgd->bghqj', qb, k_cmp).astype(f32) * scale
               - slopes * (tf[:, None] - cmp_mid[None, :]))
        p_c = masked_softmax(s_c, cmp_end[None, :] <= t[:, None])
        o_c = jnp.einsum('bghqj,bjgd->bqghd', p_c.astype(v_cmp.dtype), v_cmp)
        imp = jnp.einsum('bghqj,ji->bgqi', p_c, overlap)
        cur = (t // SLC_BLOCK)[:, None]
        valid = slc_i[None, :] * SLC_BLOCK <= t[:, None]
        forced = (slc_i[None, :] == 0) | (slc_i[None, :] == cur) | (slc_i[None, :] == cur - 1)
        score = jnp.where(valid, imp + jnp.where(forced, FORCE_SCORE, 0.0), -1.0)
        _, top = lax.top_k(score, n_top)
        sel_pos = (top[..., None] * SLC_BLOCK + in_blk).reshape(B, G, Q_BLOCK * n_sel)
        k_s = _gather_bg(k_sel_src, sel_pos).reshape(B, G, Q_BLOCK, n_sel, DH)
        v_s = _gather_bg(v_sel_src, sel_pos).reshape(B, G, Q_BLOCK, n_sel, DH)
        sel_pos = sel_pos.reshape(B, G, 1, Q_BLOCK, n_sel)
        s_s = (jnp.einsum('bqghd,bgqnd->bghqn', qb, k_s).astype(f32) * scale
               - slopes * (tf[:, None] - sel_pos.astype(f32)))
        p_s = masked_softmax(s_s, sel_pos <= t[:, None])
        o_s = jnp.einsum('bghqn,bgqnd->bqghd', p_s.astype(v_s.dtype), v_s)
        k_w = lax.dynamic_slice_in_dim(kw_pad, s0, WINDOW + Q_BLOCK, axis=1)
        v_w = lax.dynamic_slice_in_dim(vw_pad, s0, WINDOW + Q_BLOCK, axis=1)
        kpos = s0 - WINDOW + win_off
        dist = t[:, None] - kpos[None, :]
        s_w = (jnp.einsum('bqghd,bkgd->bghqk', qb, k_w).astype(f32) * scale
               - slopes * dist.astype(f32))
        p_w = masked_softmax(s_w, (dist >= 0) & (dist < WINDOW) & (kpos[None, :] >= 0))
        o_w = jnp.einsum('bghqk,bkgd->bqghd', p_w.astype(v_w.dtype), v_w)
        o = gb[..., 0:1] * o_c + gb[..., 1:2] * o_s + gb[..., 2:3] * o_w
        return o.reshape(B, Q_BLOCK, NSA_HEADS * DH)

    starts = jnp.arange(T // Q_BLOCK, dtype=jnp.int32) * Q_BLOCK
    o = jnp.swapaxes(lax.map(block, starts), 0, 1).reshape(B, T, NSA_HEADS * DH)
    return o @ w_out


def shared_mla_kv(x, kv_norm, kv_w_a, kv_c_norm, kv_w_b, kv_k_norm, cos, sin):
    B, T, _ = x.shape
    kv_a = rms_norm(x, kv_norm) @ kv_w_a
    c_kv = rms_norm(kv_a[..., :KV_LORA], kv_c_norm)
    k_pe = kv_a[..., KV_LORA:]
    kv = (c_kv @ kv_w_b).reshape(B, T, MLA_HEADS, QK_NOPE + MLA_V)
    k = jnp.concatenate([kv[..., :QK_NOPE],
                         jnp.broadcast_to(k_pe[:, :, None, :], (B, T, MLA_HEADS, QK_ROPE))], axis=-1)
    k = rms_norm(k, kv_k_norm)
    k = jnp.concatenate([k[..., :QK_NOPE], apply_rope(k[..., QK_NOPE:], cos, sin)], axis=-1)
    return k, kv[..., QK_NOPE:]


def mla_mixer(h, k, v, w_q_a, q_a_norm, w_q_b, q_norm, w_out, cos, sin):
    B, T, _ = h.shape
    q = (rms_norm(h @ w_q_a, q_a_norm) @ w_q_b).reshape(B, T, MLA_HEADS, QK_NOPE + QK_ROPE)
    q = rms_norm(q, q_norm)
    q = jnp.concatenate([q[..., :QK_NOPE], apply_rope(q[..., QK_NOPE:], cos, sin)], axis=-1)
    scale = (QK_NOPE + QK_ROPE) ** -0.5
    kpos = jnp.arange(T)

    def block(s0):
        t = s0 + jnp.arange(Q_BLOCK)
        qb = lax.dynamic_slice_in_dim(q, s0, Q_BLOCK, axis=1)
        s = jnp.einsum('bqhd,bkhd->bhqk', qb, k).astype(jnp.float32) * scale
        p = masked_softmax(s, kpos[None, :] <= t[:, None])
        o = jnp.einsum('bhqk,bkhd->bqhd', p.astype(v.dtype), v)
        return o.reshape(B, Q_BLOCK, MLA_HEADS * MLA_V)

    starts = jnp.arange(T // Q_BLOCK, dtype=jnp.int32) * Q_BLOCK
    o = jnp.swapaxes(lax.map(block, starts), 0, 1).reshape(B, T, MLA_HEADS * MLA_V)
    return o @ w_out


def setup_inputs(seed: int = 0) -> dict:
    key = jax.random.key(seed)
    ks = iter(jax.random.split(key, 32))
    f32 = jnp.float32

    def w(shape, fan_in):
        return jax.random.normal(next(ks), shape, f32) * (fan_in ** -0.5)

    def gain(shape):
        return 1.0 + 0.02 * jax.random.normal(next(ks), shape, f32)

    def small(shape, s):
        return s * jax.random.normal(next(ks), shape, f32)

    NA, NB, D = N_A_LAYERS, N_B_LAYERS, D_MODEL
    flat = CMP_BLOCK * NSA_DH
    return {
        'x': jax.random.normal(next(ks), (BATCH, SEQ, D), f32),
        'a_attn_norm': gain((NA, D)),
        'a_w_in': w((NA, D, NSA_IN_WIDTH), D),
        'a_q_norm': gain((NA, NSA_DH)),
        'a_kcmp_norm': gain((NA, NSA_DH)),
        'a_kslc_norm': gain((NA, NSA_DH)),
        'a_kwin_norm': gain((NA, NSA_DH)),
        'a_cmp_pos_k': small((NA, CMP_BLOCK, NSA_DH), 0.02),
        'a_cmp_pos_v': small((NA, CMP_BLOCK, NSA_DH), 0.02),
        'a_cmp_k_w1': w((NA, flat, CMP_HIDDEN), flat),
        'a_cmp_k_b1': small((NA, CMP_HIDDEN), 0.01),
        'a_cmp_k_w2': w((NA, CMP_HIDDEN, NSA_DH), CMP_HIDDEN),
        'a_cmp_v_w1': w((NA, flat, CMP_HIDDEN), flat),
        'a_cmp_v_b1': small((NA, CMP_HIDDEN), 0.01),
        'a_cmp_v_w2': w((NA, CMP_HIDDEN, NSA_DH), CMP_HIDDEN),
        'a_w_out': w((NA, NSA_HEADS * NSA_DH, D), NSA_HEADS * NSA_DH),
        'kv_norm': gain((D,)),
        'kv_w_a': w((D, KV_LORA + QK_ROPE), D),
        'kv_c_norm': gain((KV_LORA,)),
        'kv_w_b': w((KV_LORA, MLA_HEADS * (QK_NOPE + MLA_V)), KV_LORA),
        'kv_k_norm': gain((QK_NOPE + QK_ROPE,)),
        'b_attn_norm': gain((NB, D)),
        'b_w_q_a': w((NB, D, Q_LORA), D),
        'b_q_a_norm': gain((NB, Q_LORA)),
        'b_w_q_b': w((NB, Q_LORA, MLA_HEADS * (QK_NOPE + QK_ROPE)), Q_LORA),
        'b_q_norm': gain((NB, QK_NOPE + QK_ROPE)),
        'b_w_out': w((NB, MLA_HEADS * MLA_V, D), MLA_HEADS * MLA_V),
        'ffn_norm': gain((DEPTH, D)),
        'ffn_w_gate_up': w((DEPTH, D, 2 * FFN_HIDDEN), D),
        'ffn_w_down': w((DEPTH, FFN_HIDDEN, D), FFN_HIDDEN),
    }


def reference(x, a_attn_norm, a_w_in, a_q_norm, a_kcmp_norm, a_kslc_norm, a_kwin_norm,
              a_cmp_pos_k, a_cmp_pos_v, a_cmp_k_w1, a_cmp_k_b1, a_cmp_k_w2,
              a_cmp_v_w1, a_cmp_v_b1, a_cmp_v_w2, a_w_out,
              kv_norm, kv_w_a, kv_c_norm, kv_w_b, kv_k_norm,
              b_attn_norm, b_w_q_a, b_q_a_norm, b_w_q_b, b_q_norm, b_w_out,
              ffn_norm, ffn_w_gate_up, ffn_w_down):
    T = x.shape[1]
    cos, sin = rope_tables(T)
    shared_k = None
    shared_v = None
    for layer in range(DEPTH):
        if layer < N_A_LAYERS:
            i = layer
            x = x + nsa_mixer(rms_norm(x, a_attn_norm[i]), a_w_in[i], a_q_norm[i],
                              a_kcmp_norm[i], a_kslc_norm[i], a_kwin_norm[i],
                              a_cmp_pos_k[i], a_cmp_pos_v[i],
                              a_cmp_k_w1[i], a_cmp_k_b1[i], a_cmp_k_w2[i],
                              a_cmp_v_w1[i], a_cmp_v_b1[i], a_cmp_v_w2[i], a_w_out[i])
        else:
            j = layer - N_A_LAYERS
            x = x + mla_mixer(rms_norm(x, b_attn_norm[j]), shared_k, shared_v,
                              b_w_q_a[j], b_q_a_norm[j], b_w_q_b[j], b_q_norm[j],
                              b_w_out[j], cos, sin)
        x = x + swiglu(rms_norm(x, ffn_norm[layer]), ffn_w_gate_up[layer], ffn_w_down[layer])
        if layer == N_A_LAYERS - 1:
            shared_k, shared_v = shared_mla_kv(x, kv_norm, kv_w_a, kv_c_norm, kv_w_b,
                                               kv_k_norm, cos, sin)
    return x
```

```cpp
#include <hip/hip_runtime.h>
#include <hip/hip_cooperative_groups.h>
#include <stdint.h>
#include <string.h>
#include <stdio.h>
namespace cg = cooperative_groups;

#ifndef COOP
#define COOP 1
#endif

typedef unsigned short bf16_t;
typedef short bf16x8 __attribute__((ext_vector_type(8)));
typedef float f32x4 __attribute__((ext_vector_type(4)));
typedef unsigned u32x4 __attribute__((ext_vector_type(4)));
typedef unsigned u32x2 __attribute__((ext_vector_type(2)));
typedef unsigned long long u64;
#define DEV __device__ __forceinline__

constexpr int T = 8192, M = 16384;
constexpr float EPS = 1e-6f;
constexpr float LOG2E = 1.4426950408889634f;
constexpr float QSCALE_NSA = 0.125f * LOG2E;
constexpr float QSCALE_MLA = 0.07216878364870322f * LOG2E;

enum { IN_X = 0, IN_A_ATTN_NORM, IN_A_W_IN, IN_A_Q_NORM, IN_A_KCMP_NORM, IN_A_KSLC_NORM, IN_A_KWIN_NORM, IN_POS_K, IN_POS_V,
       IN_K_W1, IN_K_B1, IN_K_W2, IN_V_W1, IN_V_B1, IN_V_W2, IN_A_W_OUT, IN_KV_NORM, IN_KV_W_A, IN_KV_C_NORM, IN_KV_W_B, IN_KV_K_NORM,
       IN_B_ATTN_NORM, IN_B_W_Q_A, IN_B_Q_A_NORM, IN_B_W_Q_B, IN_B_Q_NORM, IN_B_W_OUT, IN_FFN_NORM, IN_FFN_W_GU, IN_FFN_W_DN, N_IN };

constexpr size_t OFF_WT_IN = 0;
constexpr size_t OFF_WT_C1K = OFF_WT_IN + (size_t)2688 * 1088 * 2;
constexpr size_t OFF_WT_C1V = OFF_WT_C1K + (size_t)256 * 2112 * 2;
constexpr size_t OFF_WT_C2K = OFF_WT_C1V + (size_t)256 * 2112 * 2;
constexpr size_t OFF_WT_C2V = OFF_WT_C2K + (size_t)128 * 320 * 2;
constexpr size_t OFF_WT_OUT0 = OFF_WT_C2V + (size_t)128 * 320 * 2;
constexpr size_t OFF_WT_GU0 = OFF_WT_OUT0 + (size_t)1024 * 1088 * 2;
constexpr size_t OFF_WT_DN0 = OFF_WT_GU0 + (size_t)5632 * 1088 * 2;
constexpr size_t OFF_WT_KVQA = OFF_WT_DN0 + (size_t)1024 * 2880 * 2;
constexpr size_t OFF_WT_KVB = OFF_WT_KVQA + (size_t)768 * 1088 * 2;
constexpr size_t OFF_WT_QB = OFF_WT_KVB + (size_t)2048 * 320 * 2;
constexpr size_t OFF_WT_OUT1 = OFF_WT_QB + (size_t)1536 * 448 * 2;
constexpr size_t OFF_WT_GU1 = OFF_WT_OUT1 + (size_t)1024 * 1088 * 2;
constexpr size_t OFF_WT_DN1 = OFF_WT_GU1 + (size_t)5632 * 1088 * 2;
constexpr size_t OFF_B1 = OFF_WT_DN1 + (size_t)1024 * 2880 * 2;
constexpr size_t OFF_SS = OFF_B1 + 2048;
constexpr size_t OFF_GATES = OFF_SS + (size_t)6 * M * 4;
constexpr size_t OFF_HID = OFF_GATES + (size_t)M * 48 * 4;
constexpr size_t OFF_KCMP = OFF_HID + (size_t)2 * 4096 * 256 * 2;
constexpr size_t OFF_VCMPT = OFF_KCMP + (size_t)8 * 512 * 64 * 2;
constexpr size_t OFF_XB = OFF_VCMPT + (size_t)8 * 64 * 512 * 2;
constexpr int XBLD = 1088, OBLD = 1088;
constexpr size_t OFF_OBUF = OFF_XB + (size_t)M * XBLD * 2;
constexpr size_t OFF_A = OFF_OBUF + (size_t)M * OBLD * 2;
constexpr size_t OFF_PROJ = OFF_A;
constexpr size_t OFF_VSLT = OFF_PROJ + (size_t)M * 2048 * 2;
constexpr size_t OFF_VWT = OFF_VSLT + (size_t)8 * 64 * T * 2;
constexpr size_t OFF_HBUF = OFF_A;
constexpr size_t OFF_K = OFF_A;
constexpr size_t OFF_Q = OFF_K + (size_t)M * 1536 * 2;
constexpr size_t OFF_VT = OFF_XB;
constexpr size_t OFF_KVA = OFF_OBUF;
constexpr size_t OFF_BAR = OFF_Q + (size_t)M * 1536 * 2;
constexpr size_t WS_NEED = OFF_BAR + 16384;
static_assert(WS_NEED <= (size_t)256 * 1024 * 1024, "workspace layout exceeds 256 MiB");

struct TJob { const float* src; const float* gain; bf16_t* dst; int K, ldsrc, nvalid, nchunks, mode, tile0, ldd, pad; };
struct Params {
    const float* in[N_IN];
    float* out;
    unsigned char* ws;
    TJob jobs[16];
    int njobs, ntrans, ph0, ph1, abl, pad;
};

typedef float f32x2_ __attribute__((ext_vector_type(2)));
typedef __bf16 bf16x2_ __attribute__((ext_vector_type(2)));
DEV unsigned pk_bf16(float lo, float hi) { const f32x2_ v = {lo, hi}; return __builtin_bit_cast(unsigned, __builtin_convertvector(v, bf16x2_)); }
DEV int otid() { int t = threadIdx.x; asm volatile("" : "+v"(t)); return t; }
DEV float bf2f(bf16_t h) { return __uint_as_float((unsigned)h << 16); }
DEV bf16_t f2bf(float f) { return (bf16_t)(pk_bf16(f, 0.f) & 0xffffu); }
DEV void st_bf16x4(bf16_t* p, f32x4 v) { u32x2 u; u.x = pk_bf16(v[0], v[1]); u.y = pk_bf16(v[2], v[3]); *(u32x2*)p = u; }
DEV float quad_sum(float v) {
    u32x2 r = __builtin_amdgcn_permlane16_swap(__float_as_uint(v), __float_as_uint(v), false, false);
    v = __uint_as_float(r.x) + __uint_as_float(r.y);
    r = __builtin_amdgcn_permlane32_swap(__float_as_uint(v), __float_as_uint(v), false, false);
    return __uint_as_float(r.x) + __uint_as_float(r.y);
}
DEV float quad_max(float v) {
    u32x2 r = __builtin_amdgcn_permlane16_swap(__float_as_uint(v), __float_as_uint(v), false, false);
    v = fmaxf(__uint_as_float(r.x), __uint_as_float(r.y));
    r = __builtin_amdgcn_permlane32_swap(__float_as_uint(v), __float_as_uint(v), false, false);
    return fmaxf(__uint_as_float(r.x), __uint_as_float(r.y));
}
#define DPP_ADD(v, ctrl) (v) += __uint_as_float((unsigned)__builtin_amdgcn_update_dpp(0, (int)__float_as_uint(v), (ctrl), 0xF, 0xF, true))
DEV float wave_sum(float v) {
    DPP_ADD(v, 0xB1); DPP_ADD(v, 0x4E); DPP_ADD(v, 0x141); DPP_ADD(v, 0x140);
    return quad_sum(v);
}
DEV float fexp2(float x) { return __builtin_amdgcn_exp2f(x); }
DEV float sigmoidf_(float x) { return 1.f / (1.f + __expf(-x)); }
DEV f32x4 mfma16(bf16x8 a, bf16x8 b, f32x4 c) { return __builtin_amdgcn_mfma_f32_16x16x32_bf16(a, b, c, 0, 0, 0); }
DEV int take_bit(u64& lo, u64& hi) {
    const bool uselo = lo != 0ull;
    const u64 v = uselo ? lo : hi;
    if (v == 0ull) return -1;
    const int b = __builtin_ctzll(v);
    const u64 nv = v & (v - 1ull);
    lo = uselo ? nv : lo; hi = uselo ? hi : nv;
    return b + (uselo ? 0 : 64);
}
DEV u64 uni64(u64 v) { unsigned lo = __builtin_amdgcn_readfirstlane((unsigned)v), hi = __builtin_amdgcn_readfirstlane((unsigned)(v >> 32)); return ((u64)hi << 32) | lo; }

DEV void trans_tile(const TJob& jb, int lt, float* tl) {
    const int nk = jb.K >> 6, kt = lt % nk, sc = lt / nk, tid = threadIdx.x;
    float4 v[4][2];
#pragma unroll
    for (int c = 0; c < 4; ++c) {
        const int ch = sc * 4 + c;
        const int col0 = (jb.mode == 1) ? ((ch & 1) * 2816 + (ch >> 2) * 64 + ((ch >> 1) & 1) * 32) : ch * 32;
#pragma unroll
        for (int i = 0; i < 2; ++i) {
            const int idx = tid + i * 256, k = idx >> 3, col = col0 + (idx & 7) * 4;
            v[c][i] = make_float4(0.f, 0.f, 0.f, 0.f);
            if (ch < jb.nchunks && col < jb.nvalid) v[c][i] = *(const float4*)(jb.src + (size_t)(kt * 64 + k) * jb.ldsrc + col);
        }
    }
#pragma unroll
    for (int i = 0; i < 2; ++i) {
        const int idx = tid + i * 256, k = idx >> 3, c4 = (idx & 7) * 4;
        const float gn = jb.gain ? jb.gain[kt * 64 + k] : 1.f;
#pragma unroll
        for (int c = 0; c < 4; ++c) {
            float* t_ = tl + c * (64 * 33) + k * 33 + c4;
            t_[0] = v[c][i].x * gn; t_[1] = v[c][i].y * gn; t_[2] = v[c][i].z * gn; t_[3] = v[c][i].w * gn;
        }
    }
    __syncthreads();
    {
        const int n = tid >> 3, k8 = (tid & 7) * 8;
#pragma unroll
        for (int c = 0; c < 4; ++c) {
            const int ch = sc * 4 + c;
            if (ch < jb.nchunks) {
                const float* t_ = tl + c * (64 * 33) + n;
                u32x4 o;
                o.x = pk_bf16(t_[(k8 + 0) * 33], t_[(k8 + 1) * 33]); o.y = pk_bf16(t_[(k8 + 2) * 33], t_[(k8 + 3) * 33]);
                o.z = pk_bf16(t_[(k8 + 4) * 33], t_[(k8 + 5) * 33]); o.w = pk_bf16(t_[(k8 + 6) * 33], t_[(k8 + 7) * 33]);
                *(u32x4*)(jb.dst + (size_t)(ch * 32 + n) * jb.ldd + kt * 64 + k8) = o;
            }
        }
    }
    __syncthreads();
}

DEV void trans_range(const Params& p, int j0, int j1, int b0, float* tl) {
    const int t0 = p.jobs[j0].tile0, t1 = (j1 < p.njobs) ? p.jobs[j1].tile0 : p.ntrans;
    if ((int)blockIdx.x < b0) return;
    for (int it = t0 + (int)blockIdx.x - b0; it < t1; it += gridDim.x - b0) {
        int j = j0;
        while (j + 1 < j1 && it >= p.jobs[j + 1].tile0) ++j;
        trans_tile(p.jobs[j], it - p.jobs[j].tile0, tl);
    }
}

constexpr int NJOBS_L0 = 8;

DEV void phase_prologue(const Params& p, unsigned char* smem) {
    float* tl = (float*)smem;
    const int tid = threadIdx.x;
    trans_range(p, 0, NJOBS_L0, 0, tl);
    if (blockIdx.x < 32) {
        const int which = blockIdx.x >> 4, col = (blockIdx.x & 15) * 16 + (tid & 15), kl = tid >> 4;
        const float* w1 = p.in[which ? IN_V_W1 : IN_K_W1];
        const float* pe = p.in[which ? IN_POS_V : IN_POS_K];
        const float* b1 = p.in[which ? IN_V_B1 : IN_K_B1];
        float a = 0.f;
#pragma unroll 8
        for (int k = kl; k < 2048; k += 16) a += pe[k] * w1[(size_t)k * 256 + col];
        a += __shfl_xor(a, 16); a += __shfl_xor(a, 32);
        float* red = (float*)smem;
        __syncthreads();
        if ((tid & 63) < 16) red[(tid >> 6) * 16 + (tid & 15)] = a;
        __syncthreads();
        if (tid < 16) ((float*)(p.ws + OFF_B1))[which * 256 + col] = b1[col] + ((red[tid] + red[16 + tid]) + (red[32 + tid] + red[48 + tid]));
        __syncthreads();
    }
    {
        const float* x = p.in[IN_X];
        bf16_t* xb = (bf16_t*)(p.ws + OFF_XB);
        float* ss = (float*)(p.ws + OFF_SS);
        const int lane = tid & 63;
        for (int row = (blockIdx.x * 4 + (tid >> 6)) * 2; row < M; row += gridDim.x * 8) {
            float4 v[2][4];
#pragma unroll
            for (int r = 0; r < 2; ++r)
#pragma unroll
                for (int i = 0; i < 4; ++i) v[r][i] = *(const float4*)(x + (size_t)(row + r) * 1024 + i * 256 + lane * 4);
#pragma unroll
            for (int r = 0; r < 2; ++r) {
                float s_ = 0.f;
#pragma unroll
                for (int i = 0; i < 4; ++i) {
                    s_ += v[r][i].x * v[r][i].x + v[r][i].y * v[r][i].y + v[r][i].z * v[r][i].z + v[r][i].w * v[r][i].w;
                    st_bf16x4(xb + (size_t)(row + r) * XBLD + i * 256 + lane * 4, (f32x4){v[r][i].x, v[r][i].y, v[r][i].z, v[r][i].w});
                }
                s_ = wave_sum(s_);
                if (lane == 0) ss[row + r] = s_;
            }
        }
        for (int i = blockIdx.x * 256 + tid; i < 5 * M; i += gridDim.x * 256) ss[M + i] = 0.f;
    }
}

#define LAS __attribute__((address_space(3)))
#define RAW_BARRIER() do { asm volatile("s_waitcnt lgkmcnt(0)" ::: "memory"); __builtin_amdgcn_s_barrier(); asm volatile("" ::: "memory"); } while (0)
DEV void glds16_asm(const void* gsrc, unsigned lds_dst) {
    asm volatile("s_mov_b32 m0, %1\n\ts_nop 0\n\tglobal_load_lds_dwordx4 %0, off" :: "v"(gsrc), "s"(lds_dst) : "m0", "memory");
}


struct RowLin { long lda; DEV long operator()(int r) const { return (long)r * lda; } };
struct RowCmp { int colbase; DEV long operator()(int r) const { const int bg = r >> 9; int j = r & 511; if (j > 510) j = 510;
    return ((long)((bg >> 2) * T + 16 * j)) * 2048 + colbase + (bg & 3) * 64; } };

DEV void glds16_s(const void* sbase, unsigned voff, unsigned lds_dst) {
    asm volatile("s_mov_b32 m0, %2\n\ts_nop 0\n\tglobal_load_lds_dwordx4 %0, %1" :: "v"(voff), "s"(sbase), "s"(lds_dst) : "m0", "memory");
}

template <class RowMap, class Epi>
DEV void gemm_tile(const RowMap& rm, const bf16_t* __restrict__ A, long a_kstep, const bf16_t* __restrict__ Bt, int K, int tm, int tn, const Epi& epi, unsigned char* smem, int ldb_over = 0) {
    const int tid = threadIdx.x, lane = tid & 63, w = tid >> 6, wm = w >> 1, wn = w & 1, fr = lane & 15, fq = lane >> 4;
    const bf16_t* As = (const bf16_t*)smem;
    const size_t ldb_ = ldb_over ? (size_t)ldb_over : (size_t)K + 64;
    unsigned aoff[4], boff[4];
#pragma unroll
    for (int i = 0; i < 4; ++i) {
        const int row = 8 * (4 * w + i) + (lane >> 3), c = (lane & 7) ^ ((4 * i + (lane >> 4)) & 7);
        aoff[i] = (unsigned)((rm(tm * 128 + row) + c * 8) * 2);
        boff[i] = (unsigned)(((size_t)(tn * 128 + row) * ldb_ + c * 8) * 2);
    }
    const unsigned lds_u = (unsigned)(unsigned long long)(LAS unsigned char*)smem + (unsigned)(4 * w) * 1024u;
    unsigned la[2][4];
#pragma unroll
    for (int b_ = 0; b_ < 2; ++b_)
#pragma unroll
        for (int i = 0; i < 4; ++i) la[b_][i] = (unsigned)__builtin_amdgcn_readfirstlane((int)(lds_u + (unsigned)b_ * 32768u + (unsigned)i * 1024u));
#define GEMM_ISSUE(kt_, buf_) do { const bf16_t* ab_ = A + (long)(kt_) * a_kstep; const bf16_t* bb_ = Bt + (long)(kt_) * 64; \
        _Pragma("unroll") for (int i_ = 0; i_ < 4; ++i_) { glds16_s(ab_, aoff[i_], la[buf_][i_]); glds16_s(bb_, boff[i_], la[buf_][i_] + 16384u); } } while (0)
#define GEMM_ISSUE1(kt_, buf_, i_) do { glds16_s(A + (long)(kt_) * a_kstep, aoff[i_], la[buf_][i_]); glds16_s(Bt + (long)(kt_) * 64, boff[i_], la[buf_][i_] + 16384u); } while (0)
    f32x4 acc[4][4];
#pragma unroll
    for (int a = 0; a < 4; ++a)
#pragma unroll
        for (int b = 0; b < 4; ++b) acc[a][b] = (f32x4){0.f, 0.f, 0.f, 0.f};
    const int nk = K >> 6;
    const int fsw = (fr >> 1) & 7;
    __syncthreads();
    GEMM_ISSUE(0, 0);
    for (int kt = 0; kt < nk; ++kt) {
        asm volatile("s_waitcnt vmcnt(0)" ::: "memory");
        RAW_BARRIER();
        const bool nxt = kt + 1 < nk;
        const int bo = (kt & 1) * 16384;
#pragma unroll
        for (int ks = 0; ks < 2; ++ks) {
            bf16x8 af[4], bfr[4];
#pragma unroll
            for (int i = 0; i < 4; ++i) { af[i] = *(const bf16x8*)(As + bo + (wm * 64 + i * 16 + fr) * 64 + (((ks * 4 + fq) ^ fsw) * 8)); bfr[i] = *(const bf16x8*)(As + bo + 8192 + (wn * 64 + i * 16 + fr) * 64 + (((ks * 4 + fq) ^ fsw) * 8)); }
#pragma unroll
            for (int mi = 0; mi < 4; ++mi) {
#pragma unroll
                for (int ni = 0; ni < 4; ++ni) acc[mi][ni] = mfma16(bfr[ni], af[mi], acc[mi][ni]);
                if (ks == 0 && nxt) { if (kt & 1) GEMM_ISSUE1(kt + 1, 0, mi); else GEMM_ISSUE1(kt + 1, 1, mi); }
            }
        }
    }
#undef GEMM_ISSUE
#undef GEMM_ISSUE1
    epi(acc, tm * 128 + wm * 64, tn * 128 + wn * 64, fr, fq);
}

template <class Epi>
DEV void gemm_tile_big(long lda, const bf16_t* __restrict__ A, const bf16_t* __restrict__ Bt, int K, int tm, int tn, const Epi& epi, unsigned char* smem) {
    bf16_t* As = (bf16_t*)smem; bf16_t* Bs = As + 256 * 64;
    const int tid = threadIdx.x, lane = tid & 63, w = tid >> 6, wm = w >> 1, wn = w & 1, fr = lane & 15, fq = lane >> 4;
    const int c0_ = (tid & 7) * 8;
    const bf16_t* const ap0 = A + (long)(tm * 256 + (tid >> 3)) * lda + c0_;
    const long astep = 32 * lda;
    const size_t ldb_ = (size_t)K + 64;
    const bf16_t* const bp0 = Bt + (size_t)(tn * 128 + (tid >> 3)) * ldb_ + c0_;
    const size_t bstep = 32 * ldb_;
    f32x4 acc[2][4][4];
#pragma unroll
    for (int h = 0; h < 2; ++h)
#pragma unroll
        for (int a = 0; a < 4; ++a)
#pragma unroll
            for (int b = 0; b < 4; ++b) acc[h][a][b] = (f32x4){0.f, 0.f, 0.f, 0.f};
    u32x4 ra[8], rb[4];
    const int nk = K >> 6;
    const int sto = (tid >> 3) * 64 + (((tid & 7) ^ ((tid >> 4) & 7)) * 8);
    const int fsw = (fr >> 1) & 7;
#pragma unroll
    for (int i = 0; i < 8; ++i) ra[i] = *(const u32x4*)(ap0 + i * astep);
#pragma unroll
    for (int i = 0; i < 4; ++i) rb[i] = *(const u32x4*)(bp0 + i * bstep);
    for (int kt = 0; kt < nk; ++kt) {
        __syncthreads();
#pragma unroll
        for (int i = 0; i < 8; ++i) *(u32x4*)(As + sto + i * 32 * 64) = ra[i];
#pragma unroll
        for (int i = 0; i < 4; ++i) *(u32x4*)(Bs + sto + i * 32 * 64) = rb[i];
        __syncthreads();
        if (kt + 1 < nk) {
#pragma unroll
            for (int i = 0; i < 8; ++i) ra[i] = *(const u32x4*)(ap0 + i * astep + (kt + 1) * 64);
#pragma unroll
            for (int i = 0; i < 4; ++i) rb[i] = *(const u32x4*)(bp0 + i * bstep + (kt + 1) * 64);
        }
#pragma unroll
        for (int ks = 0; ks < 2; ++ks) {
            bf16x8 bfr[4];
#pragma unroll
            for (int i = 0; i < 4; ++i) bfr[i] = *(const bf16x8*)(Bs + (wn * 64 + i * 16 + fr) * 64 + (((ks * 4 + fq) ^ fsw) * 8));
#pragma unroll
            for (int h = 0; h < 2; ++h) {
                bf16x8 af[4];
#pragma unroll
                for (int i = 0; i < 4; ++i) af[i] = *(const bf16x8*)(As + (wm * 128 + h * 64 + i * 16 + fr) * 64 + (((ks * 4 + fq) ^ fsw) * 8));
#pragma unroll
                for (int mi = 0; mi < 4; ++mi)
#pragma unroll
                    for (int ni = 0; ni < 4; ++ni) acc[h][mi][ni] = mfma16(bfr[ni], af[mi], acc[h][mi][ni]);

            }
        }
    }
    epi(acc[0], tm * 256 + wm * 128, tn * 128 + wn * 64, fr, fq);
    epi(acc[1], tm * 256 + wm * 128 + 64, tn * 128 + wn * 64, fr, fq);
}

DEV void store_vt_tile(const f32x4 (&acc)[4][4], const float (&sc)[4], bf16_t* dst, long ldt, unsigned char* smem, int fr, int fq) {
    __syncthreads();
    bf16_t* L = (bf16_t*)smem + (threadIdx.x >> 6) * (64 * 72);
#pragma unroll
    for (int mi = 0; mi < 4; ++mi)
#pragma unroll
        for (int ni = 0; ni < 4; ++ni)
#pragma unroll
            for (int r = 0; r < 4; ++r) L[(ni * 16 + fq * 4 + r) * 72 + mi * 16 + fr] = f2bf(acc[mi][ni][r] * sc[mi]);
    const int lane = threadIdx.x & 63;
#pragma unroll
    for (int j = 0; j < 8; ++j) { const int q = lane + 64 * j, d = q >> 3, c = (q & 7) * 8; *(u32x4*)(dst + (long)d * ldt + c) = *(const u32x4*)(L + d * 72 + c); }
}

struct EpiInProj {
    const float* ss0; const float* qn; const float* kslcn; const float* kwinn; bf16_t* proj; bf16_t* vslt; bf16_t* vwt; float* gates; unsigned char* smem;
    DEV void operator()(f32x4 (&acc)[4][4], int row0, int col0, int fr, int fq) const {
        const int cb = col0 >> 6;
        if (cb >= 41) return;
#pragma unroll
        for (int mi = 0; mi < 4; ++mi) {
            const float rstd = rsqrtf(ss0[row0 + mi * 16 + fr] * (1.f / 1024.f) + EPS);
#pragma unroll
            for (int ni = 0; ni < 4; ++ni) acc[mi][ni] *= rstd;
        }
        const bool isq = cb < 16, isksl = (cb >= 24 && cb < 28), iskw = (cb >= 32 && cb < 36);
        if (isq || isksl || iskw) {
            const int dstcol = isq ? cb * 64 : (isksl ? 1536 + (cb - 24) * 64 : 1792 + (cb - 32) * 64);
            const float extra = isq ? QSCALE_NSA : 1.f;
#pragma unroll
            for (int mi = 0; mi < 4; ++mi) {
                float ss = 0.f;
#pragma unroll
                for (int ni = 0; ni < 4; ++ni) { const f32x4 v = acc[mi][ni]; ss += v[0] * v[0] + v[1] * v[1] + v[2] * v[2] + v[3] * v[3]; }
                ss = quad_sum(ss);
                const float r2 = rsqrtf(ss * (1.f / 64.f) + EPS) * extra;
                const long row = row0 + mi * 16 + fr;
#pragma unroll
                for (int ni = 0; ni < 4; ++ni) {
                    const f32x4 gq = *(const f32x4*)(qn + ni * 16 + fq * 4), gs = *(const f32x4*)(kslcn + ni * 16 + fq * 4), gw = *(const f32x4*)(kwinn + ni * 16 + fq * 4);
                    const f32x4 g4 = isq ? gq : (isksl ? gs : gw);
                    st_bf16x4(proj + row * 2048 + dstcol + ni * 16 + fq * 4, acc[mi][ni] * r2 * g4);
                }
            }
        } else if ((cb >= 16 && cb < 24)) {
            const int dstcol = 1024 + (cb - 16) * 64;
#pragma unroll
            for (int mi = 0; mi < 4; ++mi) { const long row = row0 + mi * 16 + fr;
#pragma unroll
                for (int ni = 0; ni < 4; ++ni) st_bf16x4(proj + row * 2048 + dstcol + ni * 16 + fq * 4, acc[mi][ni]); }
        } else if ((cb >= 28 && cb < 32) || (cb >= 36 && cb < 40)) {
            bf16_t* dst = cb < 32 ? vslt : vwt; const int g = cb < 32 ? cb - 28 : cb - 36;
            const int b = row0 >> 13, t0 = row0 & (T - 1);
            const float one4[4] = {1.f, 1.f, 1.f, 1.f};
            store_vt_tile(acc, one4, dst + ((long)((b * 4 + g) * 64)) * T + t0, T, smem, fr, fq);
        } else if (cb == 40) {
#pragma unroll
            for (int mi = 0; mi < 4; ++mi) { const long row = row0 + mi * 16 + fr;
#pragma unroll
                for (int ni = 0; ni < 3; ++ni) { f32x4 v = acc[mi][ni];
#pragma unroll
                    for (int r = 0; r < 4; ++r) v[r] = sigmoidf_(v[r]);
                    *(f32x4*)(gates + row * 48 + ni * 16 + fq * 4) = v; } }
        }
    }
};

struct EpiCmp1P {
    float* part;
    DEV void operator()(f32x4 (&acc)[4][4], int row0, int col0, int fr, int fq) const {
#pragma unroll
        for (int mi = 0; mi < 4; ++mi)
#pragma unroll
            for (int ni = 0; ni < 4; ++ni) *(f32x4*)(part + (long)(row0 + mi * 16 + fr) * 256 + col0 + ni * 16 + fq * 4) = acc[mi][ni];
    }
};

struct EpiCmp1 {
    const float* b1; bf16_t* hid;
    DEV void operator()(f32x4 (&acc)[4][4], int row0, int col0, int fr, int fq) const {
#pragma unroll
        for (int ni = 0; ni < 4; ++ni) { const f32x4 bv = *(const f32x4*)(b1 + col0 + ni * 16 + fq * 4);
#pragma unroll
            for (int mi = 0; mi < 4; ++mi) { f32x4 v = acc[mi][ni] + bv;
#pragma unroll
                for (int r = 0; r < 4; ++r) { const float x = v[r]; const float u = 0.7978845608028654f * (x + 0.044715f * x * x * x); v[r] = x * sigmoidf_(2.f * u); }
                st_bf16x4(hid + (long)(row0 + mi * 16 + fr) * 256 + col0 + ni * 16 + fq * 4, v); } }
    }
};

struct EpiCmp2 {
    int which; const float* gain; bf16_t* kcmp; bf16_t* vcmpt;
    DEV void operator()(f32x4 (&acc)[4][4], int row0, int col0, int fr, int fq) const {
        if (col0 != 0) return;
        if (which == 0) {
#pragma unroll
            for (int mi = 0; mi < 4; ++mi) {
                float ss = 0.f;
#pragma unroll
                for (int ni = 0; ni < 4; ++ni) { const f32x4 v = acc[mi][ni]; ss += v[0] * v[0] + v[1] * v[1] + v[2] * v[2] + v[3] * v[3]; }
                ss = quad_sum(ss);
                const float r2 = rsqrtf(ss * (1.f / 64.f) + EPS);
                const long row = row0 + mi * 16 + fr;
#pragma unroll
                for (int ni = 0; ni < 4; ++ni) { const f32x4 g4 = *(const f32x4*)(gain + ni * 16 + fq * 4); st_bf16x4(kcmp + row * 64 + ni * 16 + fq * 4, acc[mi][ni] * r2 * g4); }
            }
        } else {
#pragma unroll
            for (int mi = 0; mi < 4; ++mi) { const int row = row0 + mi * 16 + fr, bg = row >> 9, j = row & 511;
#pragma unroll
                for (int ni = 0; ni < 4; ++ni)
#pragma unroll
                    for (int r = 0; r < 4; ++r) vcmpt[((long)(bg * 64 + ni * 16 + fq * 4 + r)) * 512 + j] = f2bf(acc[mi][ni][r]); }
        }
    }
};

struct EpiResid {
    const float* base; float* out; bf16_t* xb; float* ssn;
    DEV void operator()(f32x4 (&acc)[4][4], int row0, int col0, int fr, int fq) const {
#pragma unroll
        for (int mi = 0; mi < 4; ++mi) {
            const long row = row0 + mi * 16 + fr; float ss = 0.f;
#pragma unroll
            for (int ni = 0; ni < 4; ++ni) {
                const long off = row * 1024 + col0 + ni * 16 + fq * 4;
                const f32x4 v = *(const f32x4*)(base + off) + acc[mi][ni];
                *(f32x4*)(out + off) = v;
                if (ssn) { st_bf16x4(xb + row * XBLD + col0 + ni * 16 + fq * 4, v); ss += v[0] * v[0] + v[1] * v[1] + v[2] * v[2] + v[3] * v[3]; }
            }
            if (ssn) { ss = quad_sum(ss); if (fq == 0) atomicAdd(ssn + row, ss); }
        }
    }
};

struct EpiGateUp {
    const float* ss; bf16_t* hbuf;
    DEV void operator()(f32x4 (&acc)[4][4], int row0, int col0, int fr, int fq) const {
        const int hc0 = (col0 >> 7) * 64 + ((col0 >> 6) & 1) * 32;
#pragma unroll
        for (int mi = 0; mi < 4; ++mi) {
            const long row = row0 + mi * 16 + fr;
            const float rstd = rsqrtf(ss[row] * (1.f / 1024.f) + EPS);
#pragma unroll
            for (int ni = 0; ni < 2; ++ni) {
                f32x4 g = acc[mi][ni] * rstd, u = acc[mi][ni + 2] * rstd, h;
#pragma unroll
                for (int r = 0; r < 4; ++r) h[r] = g[r] * sigmoidf_(g[r]) * u[r];
                st_bf16x4(hbuf + row * 2816 + hc0 + ni * 16 + fq * 4, h);
            }
        }
    }
};

struct EpiKvqa {
    const float* ss; bf16_t* kva; float* ssc; float* ssq;
    DEV void operator()(f32x4 (&acc)[4][4], int row0, int col0, int fr, int fq) const {
        const int cb = col0 >> 6;
        if (cb >= 11) return;
#pragma unroll
        for (int mi = 0; mi < 4; ++mi) {
            const long row = row0 + mi * 16 + fr;
            const float rstd = rsqrtf(ss[row] * (1.f / 1024.f) + EPS);
            float s2 = 0.f;
#pragma unroll
            for (int ni = 0; ni < 4; ++ni) { const f32x4 v = acc[mi][ni] * rstd; s2 += v[0] * v[0] + v[1] * v[1] + v[2] * v[2] + v[3] * v[3];
                st_bf16x4(kva + row * 768 + col0 + ni * 16 + fq * 4, v); }
            s2 = quad_sum(s2);
            if (fq == 0) { if (cb < 4) atomicAdd(ssc + row, s2); else if (cb >= 5) atomicAdd(ssq + row, s2); }
        }
    }
};

struct EpiKvb {
    const float* ssc; bf16_t* kbuf; bf16_t* vt; unsigned char* smem;
    DEV void operator()(f32x4 (&acc)[4][4], int row0, int col0, int fr, int fq) const {
        const int cb = col0 >> 6, h = cb >> 2, sub = cb & 3;
        float rstd[4];
#pragma unroll
        for (int mi = 0; mi < 4; ++mi) rstd[mi] = rsqrtf(ssc[row0 + mi * 16 + fr] * (1.f / 256.f) + EPS);
        if (sub < 2) {
#pragma unroll
            for (int mi = 0; mi < 4; ++mi)
#pragma unroll
                for (int ni = 0; ni < 4; ++ni) st_bf16x4(kbuf + (long)(row0 + mi * 16 + fr) * 1536 + h * 192 + sub * 64 + ni * 16 + fq * 4, acc[mi][ni] * rstd[mi]);
        } else {
            const int b = row0 >> 13, t0 = row0 & (T - 1);
            store_vt_tile(acc, rstd, vt + ((long)((b * 8 + h) * 128 + (sub - 2) * 64)) * T + t0, T, smem, fr, fq);
        }
    }
};

struct EpiQb {
    const float* ssq; bf16_t* qbuf;
    DEV void operator()(f32x4 (&acc)[4][4], int row0, int col0, int fr, int fq) const {
#pragma unroll
        for (int mi = 0; mi < 4; ++mi) {
            const long row = row0 + mi * 16 + fr;
            const float rstd = rsqrtf(ssq[row] * (1.f / 384.f) + EPS);
#pragma unroll
            for (int ni = 0; ni < 4; ++ni) st_bf16x4(qbuf + row * 1536 + col0 + ni * 16 + fq * 4, acc[mi][ni] * rstd);
        }
    }
};


template <int MODE, bool MASK>
DEV void nsa_compute(const LAS unsigned char* Ks, const LAS unsigned char* Vs, int tt, const bf16x8 (&qf)[2], int t, const f32x4 (&bias)[4], float dl, bool selbit,
                     float& l, float invl, f32x4 (&O)[4], f32x4& lacc, float* IA, float& carry, int tokl, int fr, int fq) {
    const int fsw = (fr >> 1) & 7;
    f32x4 s[4];
#pragma unroll
    for (int k16 = 0; k16 < 4; ++k16) {
        s[k16] = bias[k16];
#pragma unroll
        for (int ks = 0; ks < 2; ++ks) { const bf16x8 kf = *(const LAS bf16x8*)(Ks + (k16 * 16 + fr) * 128 + (((ks * 4 + fq) ^ fsw) * 16)); s[k16] = mfma16(kf, qf[ks], s[k16]); }
    }
    if (MASK) {
#pragma unroll
        for (int k16 = 0; k16 < 4; ++k16)
#pragma unroll
            for (int r = 0; r < 4; ++r) {
                const int e = tt * 64 + k16 * 16 + fq * 4 + r;
                bool valid;
                if (MODE <= 1) valid = (16 * e + 31 <= t);
                else if (MODE == 2) valid = (e <= t);
                else valid = (e <= t) && (t - e < 512);
                s[k16][r] = valid ? s[k16][r] : -INFINITY;
            }
    }
    float sh = dl;
    if (MODE == 2) sh = selbit ? dl : -INFINITY;
    if (MODE == 0) {
        float ps = 0.f;
#pragma unroll
        for (int k16 = 0; k16 < 4; ++k16)
#pragma unroll
            for (int r = 0; r < 4; ++r) ps += fexp2(s[k16][r] + sh);
        l += ps;
        return;
    }
    {
        float ps = 0.f;
#pragma unroll
        for (int k16 = 0; k16 < 4; ++k16)
#pragma unroll
            for (int r = 0; r < 4; ++r) s[k16][r] = fexp2(s[k16][r] + sh);
        (void)ps;
    }
    if (MODE == 1) {
#pragma unroll
        for (int k16 = 0; k16 < 4; ++k16) s[k16] *= invl;
        const int lane = fq * 16 + fr;
#pragma unroll
        for (int k16 = 0; k16 < 4; ++k16) {
            f32x4 v = s[k16];
#pragma unroll
            for (int r = 0; r < 4; ++r) { DPP_ADD(v[r], 0xB1); DPP_ADD(v[r], 0x4E); }
            const float y = __shfl(v[3], (lane + 48) & 63);
            const float prev = fq > 0 ? y : carry;
            carry = y;
            if ((fr & 3) == 0) IA[tokl * 132 + tt * 16 + k16 * 4 + fq] = ((v[0] + v[1]) + (v[2] + v[3])) + prev;
        }
    }
#pragma unroll
    for (int ks2 = 0; ks2 < 2; ++ks2) {
        u32x4 pu;
        pu.x = pk_bf16(s[2 * ks2][0], s[2 * ks2][1]); pu.y = pk_bf16(s[2 * ks2][2], s[2 * ks2][3]);
        pu.z = pk_bf16(s[2 * ks2 + 1][0], s[2 * ks2 + 1][1]); pu.w = pk_bf16(s[2 * ks2 + 1][2], s[2 * ks2 + 1][3]);
        const bf16x8 pb = __builtin_bit_cast(bf16x8, pu);
        if (MODE >= 2) { u32x4 ou; ou.x = 0x3F803F80u; ou.y = 0x3F803F80u; ou.z = 0x3F803F80u; ou.w = 0x3F803F80u; lacc = mfma16(__builtin_bit_cast(bf16x8, ou), pb, lacc); }
#pragma unroll
        for (int dt = 0; dt < 4; ++dt) {
            const LAS unsigned char* vr = Vs + (dt * 16 + fr) * 128 + (fq & 1) * 8;
            const u32x2 v0 = *(const LAS u32x2*)(vr + (((ks2 * 4 + (fq >> 1)) ^ fsw) * 16));
            const u32x2 v1 = *(const LAS u32x2*)(vr + (((ks2 * 4 + (fq >> 1) + 2) ^ fsw) * 16));
            u32x4 vv; vv.x = v0.x; vv.y = v0.y; vv.z = v1.x; vv.w = v1.y;
            O[dt] = mfma16(__builtin_bit_cast(bf16x8, vv), pb, O[dt]);
        }
    }
}

DEV int take_bit_hi(u64& lo, u64& hi) {
    const bool usehi = hi != 0ull;
    const u64 v = usehi ? hi : lo;
    if (v == 0ull) return -1;
    const int b = 63 - __builtin_clzll(v);
    const u64 nv = v & ~(1ull << b);
    hi = usehi ? nv : hi; lo = usehi ? lo : nv;
    return b + (usehi ? 64 : 0);
}
template <int MODE> DEV int take_tile(u64& lo, u64& hi) { if (MODE >= 2) return take_bit_hi(lo, hi); else return take_bit(lo, hi); }

template <int MODE>
DEV void nsa_branch(u64 mlo, u64 mhi, u64 wlo, u64 whi, const bf16_t* kbase, long ktstride, long krs, const bf16_t* vbase, long vrs,
                    LAS unsigned char* ring, const bf16x8 (&qf)[2], int t, int s0, const f32x4 (&bias)[4], float slope2, float cadj, u64 tm0, u64 tm1,
                    float& l, float invl, f32x4 (&O)[4], f32x4& lacc, float* IA, int tokl, int fr, int fq, int abl = 0) {
    const int tid = threadIdx.x, lane = tid & 63, w = tid >> 6;
    const int t0 = take_tile<MODE>(mlo, mhi);
    if (t0 < 0) return;
    unsigned koff[2], voff[2];
#pragma unroll
    for (int j = 0; j < 2; ++j) { const int row = 8 * (w * 2 + j) + (lane >> 3), c = (lane & 7) ^ (((lane >> 4) + 4 * j) & 7); koff[j] = (unsigned)(((long)row * krs + c * 8) * 2); voff[j] = (unsigned)(((long)row * vrs + c * 8) * 2); }
    const unsigned ring_u = (unsigned)(unsigned long long)ring + (unsigned)(w * 2) * 1024u;
#define NSA_ISSUE(tt_, slot_) do { const bf16_t* kb_ = kbase + (long)(tt_) * ktstride; const bf16_t* vb_ = vbase + (long)(tt_) * 64; \
        _Pragma("unroll") for (int j_ = 0; j_ < 2; ++j_) { \
            const unsigned la_ = (unsigned)__builtin_amdgcn_readfirstlane((int)(ring_u + (unsigned)(slot_) * 16384u + (unsigned)j_ * 1024u)); \
            glds16_s(kb_, koff[j_], la_); glds16_s(vb_, voff[j_], la_ + 8192u); } } while (0)
    const int t1 = take_tile<MODE>(mlo, mhi);
    NSA_ISSUE(t0, 0);
    if (t1 >= 0) NSA_ISSUE(t1, 1);
    int cur = t0, nxt = t1, slot = 0;
    float carry = 0.f;
    while (true) {
        const int nn = (nxt >= 0) ? take_tile<MODE>(mlo, mhi) : -1;
        if (nxt >= 0) asm volatile("s_waitcnt vmcnt(4)" ::: "memory"); else asm volatile("s_waitcnt vmcnt(0)" ::: "memory");
        RAW_BARRIER();
        if (nn >= 0) NSA_ISSUE(nn, (slot == 0 ? 2 : slot - 1));
        const bool wact = (((cur < 64 ? wlo : whi) >> (cur & 63)) & 1ull) != 0ull;
        if (wact && !(abl & 16)) {
            const bool selbit = (((cur < 64 ? tm0 : tm1) >> (cur & 63)) & 1ull) != 0ull;
            bool needmask; float dl;
            if (MODE <= 1) { needmask = 16 * (64 * cur + 63) + 31 > s0; dl = slope2 * (float)(1024 * cur - s0) + cadj; }
            else if (MODE == 2) { needmask = 64 * cur + 63 > s0; dl = slope2 * (float)(64 * cur - s0) + cadj; }
            else { needmask = (64 * cur + 63 > s0) || (64 * cur < s0 + 15 - 511); dl = slope2 * (float)(64 * cur - s0) + cadj; }
            if (needmask) nsa_compute<MODE, true>(ring + slot * 16384, ring + slot * 16384 + 8192, cur, qf, t, bias, dl, selbit, l, invl, O, lacc, IA, carry, tokl, fr, fq);
            else nsa_compute<MODE, false>(ring + slot * 16384, ring + slot * 16384 + 8192, cur, qf, t, bias, dl, selbit, l, invl, O, lacc, IA, carry, tokl, fr, fq);
        }
        if (nxt < 0) break;
        cur = nxt; nxt = nn; slot = (slot == 2 ? 0 : slot + 1);
    }
    RAW_BARRIER();
#undef NSA_ISSUE
}

DEV void nsa_item(const Params& p, unsigned char* smem, int bg, int s0, float Cc, float Cs, float cadj_w) {
    LAS unsigned char* ring = (LAS unsigned char*)smem;
    float* IA = (float*)(smem + 49152);
    u64* SELM = (u64*)(smem + 49152 + 16 * 132 * 4);
    const bf16_t* proj = (const bf16_t*)(p.ws + OFF_PROJ);
    const bf16_t* kcmp = (const bf16_t*)(p.ws + OFF_KCMP); const bf16_t* vcmpt = (const bf16_t*)(p.ws + OFF_VCMPT);
    const bf16_t* vslt = (const bf16_t*)(p.ws + OFF_VSLT); const bf16_t* vwt = (const bf16_t*)(p.ws + OFF_VWT);
    const float* gates = (const float*)(p.ws + OFF_GATES);
    bf16_t* obuf = (bf16_t*)(p.ws + OFF_OBUF);
    const int b = bg >> 2, g = bg & 3;
    const int tid = threadIdx.x, lane = tid & 63, w = tid >> 6, fr = lane & 15, fq = lane >> 4;
    const int tokl = w * 4 + (fr >> 2), t = s0 + tokl, head = g * 4 + (fr & 3);
    const float slope2 = exp2f(-0.5f * (float)(head + 1)) * LOG2E;
    const long row = (long)b * T + t;
    bf16x8 qf[2];
#pragma unroll
    for (int ks = 0; ks < 2; ++ks) qf[ks] = *(const bf16x8*)(proj + row * 2048 + head * 64 + ks * 32 + fq * 8);
    f32x4 bias[4];
#pragma unroll
    for (int k16 = 0; k16 < 4; ++k16)
#pragma unroll
        for (int r = 0; r < 4; ++r) bias[k16][r] = slope2 * ((float)(16 * (k16 * 16 + fq * 4 + r)) + 15.5f - (float)tokl) - Cc;
    float g0 = gates[row * 48 + head * 3 + 0], g1 = gates[row * 48 + head * 3 + 1], g2 = gates[row * 48 + head * 3 + 2];
    asm volatile("" : "+v"(qf[0]), "+v"(qf[1]), "+v"(g0), "+v"(g1), "+v"(g2));
    for (int i = tid; i < 16 * 132; i += 256) IA[i] = 0.f;
    __syncthreads();
    const u64 FULL = ~0ull;
    const int nc = ((s0 >> 4) + 63) >> 6;
    const u64 clo = nc ? ((1ull << nc) - 1ull) : 0ull;
    float l = 0.f;
    f32x4 O[4], lacc = (f32x4){0.f, 0.f, 0.f, 0.f};
#pragma unroll
    for (int dt = 0; dt < 4; ++dt) O[dt] = (f32x4){0.f, 0.f, 0.f, 0.f};
    const bf16_t* kcb = kcmp + (long)bg * 512 * 64; const bf16_t* vcb = vcmpt + (long)bg * 64 * 512;
    if (!(p.abl & 1)) {
    nsa_branch<0>(clo, 0ull, FULL, FULL, kcb, 64 * 64, 64, vcb, 512, ring, qf, t, s0, bias, slope2, 0.f, 0ull, 0ull, l, 0.f, O, lacc, IA, tokl, fr, fq);
    l = quad_sum(l);
    float invl_c = l > 0.f ? 1.f / l : 0.f;
    nsa_branch<1>(clo, 0ull, FULL, FULL, kcb, 64 * 64, 64, vcb, 512, ring, qf, t, s0, bias, slope2, 0.f, 0ull, 0ull, l, invl_c, O, lacc, IA, tokl, fr, fq);
    }
    f32x4 outacc[4];
#pragma unroll
    for (int dt = 0; dt < 4; ++dt) outacc[dt] = O[dt] * g0;
    __syncthreads();
    if (!(p.abl & 2)) {
#pragma unroll
    for (int k = 0; k < 4; ++k) {
        const int tk = w * 4 + k, tt_ = s0 + tk, curb = tt_ >> 6;
#pragma unroll
        for (int hh = 0; hh < 2; ++hh) {
            const int blk = lane + 64 * hh;
            const float imp = IA[tk * 132 + blk];
            const bool valid = blk <= curb, forced = (blk == 0) || (blk == curb) || (blk == curb - 1);
            IA[tk * 132 + blk] = valid ? imp + (forced ? 1e4f : 0.f) : -1.f;
        }
    }
    __syncthreads();
    {
        unsigned ka[4], kb[4], th[4];
#pragma unroll
        for (int k = 0; k < 4; ++k) {
            const int tk = w * 4 + k;
            const float a = IA[tk * 132 + lane], bsc = IA[tk * 132 + lane + 64];
            ka[k] = a >= 0.f ? __float_as_uint(a) + 1u : 0u; kb[k] = bsc >= 0.f ? __float_as_uint(bsc) + 1u : 0u; th[k] = 0u;
        }
#pragma unroll 1
        for (int bit = 30; bit >= 0; --bit) {
#pragma unroll
            for (int k = 0; k < 4; ++k) {
                const unsigned cand = th[k] | (1u << bit);
                const int c = __builtin_popcountll(__ballot(ka[k] >= cand)) + __builtin_popcountll(__ballot(kb[k] >= cand));
                th[k] = c >= 16 ? cand : th[k];
            }
        }
#pragma unroll
        for (int k = 0; k < 4; ++k) {
            const int tk = w * 4 + k;
            u64 m0, m1;
            if (th[k] == 0u) { m0 = __ballot(ka[k] > 0u); m1 = __ballot(kb[k] > 0u); }
            else {
                m0 = __ballot(ka[k] > th[k]); m1 = __ballot(kb[k] > th[k]);
                u64 e0 = __ballot(ka[k] == th[k]), e1 = __ballot(kb[k] == th[k]);
                int need = 16 - (__builtin_popcountll(m0) + __builtin_popcountll(m1));
                while (need > 0 && (e0 | e1)) {
                    if (e0) { const u64 bt = e0 & (0ull - e0); m0 |= bt; e0 ^= bt; } else { const u64 bt = e1 & (0ull - e1); m1 |= bt; e1 ^= bt; }
                    --need;
                }
            }
            if (lane == 0) { SELM[tk * 2 + 0] = m0; SELM[tk * 2 + 1] = m1; }
        }
    }
    __syncthreads();
    }
    u64 ulo = 0, uhi = 0, wlo = 0, whi = 0;
    for (int k = 0; k < 16; ++k) { const u64 a = SELM[k * 2], bb = SELM[k * 2 + 1]; ulo |= a; uhi |= bb; if ((k >> 2) == w) { wlo |= a; whi |= bb; } }
    ulo = uni64(ulo); uhi = uni64(uhi); wlo = uni64(wlo); whi = uni64(whi);
    const u64 tm0 = SELM[tokl * 2], tm1 = SELM[tokl * 2 + 1];
    const bf16_t* pb_ = proj + (long)b * T * 2048 + g * 64;
#pragma unroll
    for (int k16 = 0; k16 < 4; ++k16)
#pragma unroll
        for (int r = 0; r < 4; ++r) bias[k16][r] = slope2 * (float)(k16 * 16 + fq * 4 + r - tokl) - Cs;
    {
        lacc = (f32x4){0.f, 0.f, 0.f, 0.f};
#pragma unroll
        for (int dt = 0; dt < 4; ++dt) O[dt] = (f32x4){0.f, 0.f, 0.f, 0.f};
        if (!(p.abl & 4)) nsa_branch<2>(ulo, uhi, wlo, whi, pb_ + 1536, 64 * 2048, 2048, vslt + (long)bg * 64 * T, T, ring, qf, t, s0, bias, slope2, 0.f, tm0, tm1, l, 0.f, O, lacc, IA, tokl, fr, fq, p.abl);
        const float sc = (lacc[0] > 0.f ? 1.f / lacc[0] : 0.f) * g1;
#pragma unroll
        for (int dt = 0; dt < 4; ++dt) outacc[dt] += O[dt] * sc;
    }
    {
        const int wfirst = (s0 > 511 ? s0 - 511 : 0) >> 6, wlast = (s0 + 15) >> 6;
        u64 qlo = 0, qhi = 0;
        for (int i = wfirst; i <= wlast; ++i) { if (i < 64) qlo |= 1ull << i; else qhi |= 1ull << (i - 64); }
        lacc = (f32x4){0.f, 0.f, 0.f, 0.f};
#pragma unroll
        for (int dt = 0; dt < 4; ++dt) O[dt] = (f32x4){0.f, 0.f, 0.f, 0.f};
        if (!(p.abl & 8)) nsa_branch<3>(qlo, qhi, FULL, FULL, pb_ + 1792, 64 * 2048, 2048, vwt + (long)bg * 64 * T, T, ring, qf, t, s0, bias, slope2, cadj_w, 0ull, 0ull, l, 0.f, O, lacc, IA, tokl, fr, fq, p.abl);
        const float sc = (lacc[0] > 0.f ? 1.f / lacc[0] : 0.f) * g2;
#pragma unroll
        for (int dt = 0; dt < 4; ++dt) outacc[dt] += O[dt] * sc;
    }
#pragma unroll
    for (int dt = 0; dt < 4; ++dt) st_bf16x4(obuf + row * OBLD + head * 64 + dt * 16 + fq * 4, outacc[dt]);
    __syncthreads();
}

DEV void phase_nsa(const Params& p, unsigned char* smem) {
    const int nitems = 4096, G = gridDim.x;
    float Cc, Cs, cadj_w;
    {
        const int lane = threadIdx.x & 63;
        float gq = fabsf(p.in[IN_A_Q_NORM][lane]), gc = fabsf(p.in[IN_A_KCMP_NORM][lane]), gs = fabsf(p.in[IN_A_KSLC_NORM][lane]), gw = fabsf(p.in[IN_A_KWIN_NORM][lane]);
        for (int o = 1; o < 64; o <<= 1) { gq = fmaxf(gq, __shfl_xor(gq, o)); gc = fmaxf(gc, __shfl_xor(gc, o)); gs = fmaxf(gs, __shfl_xor(gs, o)); gw = fmaxf(gw, __shfl_xor(gw, o)); }
        const float k_ = 64.f * QSCALE_NSA * 1.02f * gq;
        Cc = fminf(k_ * gc + 0.5f, 40.f); Cs = fminf(k_ * gs + 0.5f, 40.f); cadj_w = Cs - fminf(k_ * gw + 0.5f, 40.f);
        Cc = __uint_as_float(__builtin_amdgcn_readfirstlane(__float_as_uint(Cc))); Cs = __uint_as_float(__builtin_amdgcn_readfirstlane(__float_as_uint(Cs)));
        cadj_w = __uint_as_float(__builtin_amdgcn_readfirstlane(__float_as_uint(cadj_w)));
    }
    for (int rr = 0; rr * G < nitems; ++rr) {
        const int idx = (rr & 1) ? (rr + 1) * G - 1 - (int)blockIdx.x : rr * G + (int)blockIdx.x;
        if (idx >= nitems) continue;
        nsa_item(p, smem, idx & 7, (511 - (idx >> 3)) * 16, Cc, Cs, cadj_w);
    }
}

DEV void phase_finish(const Params& p) {
    bf16_t* Kb = (bf16_t*)(p.ws + OFF_K); bf16_t* Qb = (bf16_t*)(p.ws + OFF_Q); const bf16_t* kva = (const bf16_t*)(p.ws + OFF_KVA);
    const float* kn = p.in[IN_KV_K_NORM]; const float* qn = p.in[IN_B_Q_NORM];
    const int tid = threadIdx.x, lane = tid & 63;
    const float inv = (float)pow(10000.0, -(double)(lane & 31) / 32.0);
    const float kn0 = kn[2 * lane], kn1 = kn[2 * lane + 1], kn2 = kn[128 + lane];
    const float qn0 = qn[2 * lane], qn1 = qn[2 * lane + 1], qn2 = qn[128 + lane];
    for (int row = blockIdx.x * 4 + (tid >> 6); row < M; row += gridDim.x * 4) {
        const int t = row & (T - 1);
        const float ang = (float)t * inv;
        const double rev = (double)ang * 0.15915494309189535;
        const float frac = (float)(rev - rint(rev));
        const float cs = __builtin_amdgcn_cosf(frac), sn = __builtin_amdgcn_sinf(frac);
        const float pe = bf2f(kva[(long)row * 768 + 256 + lane]);
        const float pess = wave_sum(pe * pe);
#pragma unroll
        for (int h = 0; h < 8; ++h) {
            {
                bf16_t* kp = Kb + (long)row * 1536 + h * 192;
                const unsigned raw = *(const unsigned*)(kp + 2 * lane);
                float a = __uint_as_float(raw << 16), bq = __uint_as_float(raw & 0xffff0000u);
                const float ss = wave_sum(a * a + bq * bq) + pess;
                const float rs = rsqrtf(ss * (1.f / 192.f) + EPS);
                a *= rs * kn0; bq *= rs * kn1;
                const float x = pe * rs * kn2, xo = __shfl_xor(x, 32);
                const float o = lane < 32 ? x * cs - xo * sn : xo * sn + x * cs;
                *(unsigned*)(kp + 2 * lane) = pk_bf16(a, bq);
                kp[128 + lane] = f2bf(o);
            }
            {
                bf16_t* qp = Qb + (long)row * 1536 + h * 192;
                const unsigned raw = *(const unsigned*)(qp + 2 * lane);
                float a = __uint_as_float(raw << 16), bq = __uint_as_float(raw & 0xffff0000u);
                float x = bf2f(qp[128 + lane]);
                const float ss = wave_sum(a * a + bq * bq + x * x);
                const float rs = rsqrtf(ss * (1.f / 192.f) + EPS);
                a *= rs * qn0 * QSCALE_MLA; bq *= rs * qn1 * QSCALE_MLA;
                x *= rs * qn2 * QSCALE_MLA;
                const float xo = __shfl_xor(x, 32);
                const float o = lane < 32 ? x * cs - xo * sn : xo * sn + x * cs;
                *(unsigned*)(qp + 2 * lane) = pk_bf16(a, bq);
                qp[128 + lane] = f2bf(o);
            }
        }
    }
}

constexpr int MLA_QT = 2;
DEV void mla_item(const Params& p, unsigned char* smem, int bh, int qb, float negC) {
    const bf16_t* Kb = (const bf16_t*)(p.ws + OFF_K); const bf16_t* Qb = (const bf16_t*)(p.ws + OFF_Q); const bf16_t* VT = (const bf16_t*)(p.ws + OFF_VT);
    bf16_t* obuf = (bf16_t*)(p.ws + OFF_OBUF);
    const int b = bh >> 3, h = bh & 7, q0 = qb * (64 * MLA_QT);
    const int tid = threadIdx.x, lane = tid & 63, w = tid >> 6, fr = lane & 15, fq = lane >> 4;
    const int wq0 = q0 + w * (16 * MLA_QT);
    bf16x8 qf[MLA_QT][6];
#pragma unroll
    for (int qt = 0; qt < MLA_QT; ++qt)
#pragma unroll
        for (int ks = 0; ks < 6; ++ks) qf[qt][ks] = *(const bf16x8*)(Qb + ((long)b * T + wq0 + qt * 16 + fr) * 1536 + h * 192 + ks * 32 + fq * 8);
#pragma unroll
    for (int qt = 0; qt < MLA_QT; ++qt) asm volatile("" : "+v"(qf[qt][0]), "+v"(qf[qt][1]), "+v"(qf[qt][2]), "+v"(qf[qt][3]), "+v"(qf[qt][4]), "+v"(qf[qt][5]));
    f32x4 O[MLA_QT][8];
    f32x4 lacc[MLA_QT];
    u32x4 ones_u; ones_u.x = 0x3F803F80u; ones_u.y = 0x3F803F80u; ones_u.z = 0x3F803F80u; ones_u.w = 0x3F803F80u;
    const bf16x8 ones = __builtin_bit_cast(bf16x8, ones_u);
#pragma unroll
    for (int qt = 0; qt < MLA_QT; ++qt) { lacc[qt] = (f32x4){0.f, 0.f, 0.f, 0.f};
#pragma unroll
        for (int dt = 0; dt < 8; ++dt) O[qt][dt] = (f32x4){0.f, 0.f, 0.f, 0.f}; }
    const int nkt = (q0 + 64 * MLA_QT) / 64;
    const bf16_t* kg = Kb + (long)b * T * 1536 + h * 192;
    const bf16_t* vg = VT + (long)(b * 8 + h) * 128 * T;
    unsigned koff[6], voff[4];
#pragma unroll
    for (int i = 0; i < 6; ++i) { const int q = (6 * w + i) * 64 + lane, r = q / 24, cp = q % 24, c = (cp & ~7) | ((cp & 7) ^ ((r >> 1) & 7)); koff[i] = (unsigned)((r * 1536 + c * 8) * 2); }
#pragma unroll
    for (int i = 0; i < 4; ++i) { const int r = 8 * (4 * w + i) + (lane >> 3), c = (lane & 7) ^ ((r >> 1) & 7); voff[i] = (unsigned)(((long)r * T + c * 8) * 2); }
    const unsigned lds_u = (unsigned)(unsigned long long)(LAS unsigned char*)smem;
    unsigned lk[2][6], lv[4];
#pragma unroll
    for (int bb = 0; bb < 2; ++bb)
#pragma unroll
        for (int i = 0; i < 6; ++i) lk[bb][i] = (unsigned)__builtin_amdgcn_readfirstlane((int)(lds_u + (unsigned)bb * 24576u + (unsigned)(6 * w + i) * 1024u));
#pragma unroll
    for (int i = 0; i < 4; ++i) lv[i] = (unsigned)__builtin_amdgcn_readfirstlane((int)(lds_u + 49152u + (unsigned)(4 * w + i) * 1024u));
#define MLA_ISSUE_K(kt_, buf_) do { const bf16_t* kb_ = kg + (long)(kt_) * 64 * 1536; _Pragma("unroll") for (int i_ = 0; i_ < 6; ++i_) glds16_s(kb_, koff[i_], lk[buf_][i_]); } while (0)
#define MLA_ISSUE_V(kt_) do { const bf16_t* vb_ = vg + (long)(kt_) * 64; _Pragma("unroll") for (int i_ = 0; i_ < 4; ++i_) glds16_s(vb_, voff[i_], lv[i_]); } while (0)
    const int fsw = (fr >> 1) & 7;
    __syncthreads();
    MLA_ISSUE_K(0, 0);
    for (int kt = 0; kt < nkt; ++kt) {
        asm volatile("s_waitcnt vmcnt(0)" ::: "memory");
        RAW_BARRIER();
        MLA_ISSUE_V(kt);
        const bool more = kt + 1 < nkt;
        if (more) { if (kt & 1) MLA_ISSUE_K(kt + 1, 0); else MLA_ISSUE_K(kt + 1, 1); }
        const bool active = !(kt * 64 > wq0 + 16 * MLA_QT - 1);
        const unsigned char* Ks = smem + (kt & 1) * 24576;
        const unsigned char* Vs = smem + 49152;
        f32x4 s[MLA_QT][4];
        bf16x8 pb[MLA_QT][2];
        if (active) {
#pragma unroll
            for (int k16 = 0; k16 < 4; ++k16) {
                _Pragma("unroll") for (int qt = 0; qt < MLA_QT; ++qt) s[qt][k16] = (f32x4){negC, negC, negC, negC};
#pragma unroll
                for (int ks = 0; ks < 6; ++ks) {
                    const int c = ks * 4 + fq;
                    const bf16x8 kf = *(const bf16x8*)(Ks + (k16 * 16 + fr) * 384 + (((c & ~7) | ((c & 7) ^ fsw)) * 16));
#pragma unroll
                    for (int qt = 0; qt < MLA_QT; ++qt) s[qt][k16] = mfma16(kf, qf[qt][ks], s[qt][k16]);
                }
            }
            const bool needmask = kt * 64 + 63 > wq0;
#pragma unroll
            for (int qt = 0; qt < MLA_QT; ++qt) {
                if (needmask) {
                    const int qpos = wq0 + qt * 16 + fr;
#pragma unroll
                    for (int k16 = 0; k16 < 4; ++k16)
#pragma unroll
                        for (int r = 0; r < 4; ++r) { const int key = kt * 64 + k16 * 16 + fq * 4 + r; if (key > qpos) s[qt][k16][r] = -INFINITY; }
                }
#pragma unroll
                for (int k16 = 0; k16 < 4; ++k16)
#pragma unroll
                    for (int r = 0; r < 4; ++r) s[qt][k16][r] = fexp2(s[qt][k16][r]);
#pragma unroll
                for (int ks2 = 0; ks2 < 2; ++ks2) {
                    u32x4 pu;
                    pu.x = pk_bf16(s[qt][2 * ks2][0], s[qt][2 * ks2][1]); pu.y = pk_bf16(s[qt][2 * ks2][2], s[qt][2 * ks2][3]);
                    pu.z = pk_bf16(s[qt][2 * ks2 + 1][0], s[qt][2 * ks2 + 1][1]); pu.w = pk_bf16(s[qt][2 * ks2 + 1][2], s[qt][2 * ks2 + 1][3]);
                    pb[qt][ks2] = __builtin_bit_cast(bf16x8, pu);
                    lacc[qt] = mfma16(ones, pb[qt][ks2], lacc[qt]);
                }
            }
        }
        if (more) asm volatile("s_waitcnt vmcnt(6)" ::: "memory"); else asm volatile("s_waitcnt vmcnt(0)" ::: "memory");
        RAW_BARRIER();
        if (active) {
#pragma unroll
            for (int ks2 = 0; ks2 < 2; ++ks2)
#pragma unroll
                for (int dt = 0; dt < 8; ++dt) {
                    const unsigned char* vr = Vs + (dt * 16 + fr) * 128 + (fq & 1) * 8;
                    const u32x2 v0 = *(const u32x2*)(vr + (((ks2 * 4 + (fq >> 1)) ^ fsw) * 16));
                    const u32x2 v1 = *(const u32x2*)(vr + (((ks2 * 4 + (fq >> 1) + 2) ^ fsw) * 16));
                    u32x4 vv; vv.x = v0.x; vv.y = v0.y; vv.z = v1.x; vv.w = v1.y;
                    const bf16x8 vf = __builtin_bit_cast(bf16x8, vv);
#pragma unroll
                    for (int qt = 0; qt < MLA_QT; ++qt) O[qt][dt] = mfma16(vf, pb[qt][ks2], O[qt][dt]);
                }
        }
    }
#undef MLA_ISSUE_K
#undef MLA_ISSUE_V
#pragma unroll
    for (int qt = 0; qt < MLA_QT; ++qt) {
        const float lt_ = lacc[qt][0];
        const float il = lt_ > 0.f ? 1.f / lt_ : 0.f;
        const long row = (long)b * T + wq0 + qt * 16 + fr;
#pragma unroll
        for (int dt = 0; dt < 8; ++dt) st_bf16x4(obuf + row * OBLD + h * 128 + dt * 16 + fq * 4, O[qt][dt] * il);
    }
    RAW_BARRIER();
}

DEV void phase_mla(const Params& p, unsigned char* smem) {
    float negC;
    {
        const int lane = threadIdx.x & 63;
        const float* kn = p.in[IN_KV_K_NORM]; const float* qn = p.in[IN_B_Q_NORM];
        float gk = fmaxf(fmaxf(fabsf(kn[lane]), fabsf(kn[64 + lane])), fabsf(kn[128 + lane]));
        float gq = fmaxf(fmaxf(fabsf(qn[lane]), fabsf(qn[64 + lane])), fabsf(qn[128 + lane]));
        for (int o = 1; o < 64; o <<= 1) { gk = fmaxf(gk, __shfl_xor(gk, o)); gq = fmaxf(gq, __shfl_xor(gq, o)); }
        negC = -fminf(192.f * QSCALE_MLA * 1.02f * gk * gq + 0.5f, 60.f);
        negC = __uint_as_float(__builtin_amdgcn_readfirstlane(__float_as_uint(negC)));
    }
    const int nitems = 16 * (T / (64 * MLA_QT)), G = gridDim.x;
    for (int rr = 0; rr * G < nitems; ++rr) {
        const int idx = (rr & 1) ? (rr + 1) * G - 1 - (int)blockIdx.x : rr * G + (int)blockIdx.x;
        if (idx >= nitems) continue;
        mla_item(p, smem, idx & 15, (T / (64 * MLA_QT)) - 1 - (idx >> 4), negC);
    }
}


#define XB_TMO      128
#define XB_XCNT(j)  (256  + 64 * (j))
#define XB_XSUB(j)  (1280 + 64 * (j))
#define XB_XGEN(j)  (2304 + 64 * (j))
#define XB_TOP      3328
#define XB_TOPGEN   3392
#define XCD_BAR_WORDS 3456
#define XB_SPIN_CAP (1u << 20)
DEV unsigned xb_ld(unsigned* p)              { return __hip_atomic_load(p, __ATOMIC_RELAXED, __HIP_MEMORY_SCOPE_AGENT); }
DEV unsigned xb_add(unsigned* p, unsigned v) { return __hip_atomic_fetch_add(p, v, __ATOMIC_RELAXED, __HIP_MEMORY_SCOPE_AGENT); }
DEV unsigned xb_xcc_id() { return (unsigned)__builtin_amdgcn_s_getreg((3 << 11) | 20) & 0xFu; }
#define XB_SPIN(cond, bar) do { unsigned _sp = 0; while (cond) { __builtin_amdgcn_s_sleep(1); \
    if ((++_sp & 255u) == 0u) { if (xb_ld(&(bar)[XB_TMO])) break; if (_sp > XB_SPIN_CAP) { atomicAdd(&(bar)[XB_TMO], 1u); break; } } } } while (0)
struct XcdBarrier { unsigned* bar; unsigned x; volatile LAS unsigned* st; };
DEV XcdBarrier xcd_barrier_post(unsigned* bar, volatile LAS unsigned* st) {
    XcdBarrier b; b.bar = bar; b.x = xb_xcc_id(); b.st = st;
    if (threadIdx.x == 0) (void)xb_add(&bar[XB_XCNT(b.x)], 1u);
    return b;
}
DEV void xcd_barrier_complete(unsigned* bar, unsigned x, unsigned& nloc, unsigned& nx) {
    const unsigned G = gridDim.x * gridDim.y * gridDim.z;
    unsigned sum, cnt, mine, sp = 0u;
    for (;;) {
        sum = 0u; cnt = 0u; mine = 0u;
#pragma unroll
        for (unsigned j = 0; j < 16; ++j) { const unsigned c = xb_ld(&bar[XB_XCNT(j)]); sum += c; cnt += (c > 0u) ? 1u : 0u; mine = (j == x) ? c : mine; }
        if (sum == G) break;
        __builtin_amdgcn_s_sleep(1);
        if ((++sp & 255u) == 0u) { if (xb_ld(&bar[XB_TMO])) break; if (sp > XB_SPIN_CAP) { atomicAdd(&bar[XB_TMO], 1u); break; } }
    }
    nloc = mine > 0u ? mine : 1u; nx = cnt > 0u ? cnt : 1u;
}
DEV void xcd_barrier(const XcdBarrier& b) {
    asm volatile("s_waitcnt vmcnt(0)" ::: "memory");
    __syncthreads();
    if (threadIdx.x == 0) {
        unsigned* bar = b.bar;
        __builtin_amdgcn_s_waitcnt(0);
        unsigned nloc = b.st[0], nx = b.st[1];
        if (nloc == 0u) { xcd_barrier_complete(bar, b.x, nloc, nx); b.st[0] = nloc; b.st[1] = nx; }
        const unsigned old = xb_add(&bar[XB_XSUB(b.x)], 1u);
        const unsigned gen = old / nloc;
        if (old + 1u == (gen + 1u) * nloc) {
            __builtin_amdgcn_fence(__ATOMIC_RELEASE, "agent");
            asm volatile("s_waitcnt vmcnt(0)" ::: "memory");
            const unsigned og = xb_add(&bar[XB_TOP], 1u);
            const unsigned tg = og / nx;
            if (og + 1u == (tg + 1u) * nx) xb_add(&bar[XB_TOPGEN], 1u);
            else XB_SPIN(xb_ld(&bar[XB_TOPGEN]) == tg, bar);
            __builtin_amdgcn_fence(__ATOMIC_ACQUIRE, "agent");
            xb_add(&bar[XB_XGEN(b.x)], 1u);
            asm volatile("s_waitcnt vmcnt(0)" ::: "memory");
        } else {
            XB_SPIN(xb_ld(&bar[XB_XGEN(b.x)]) == gen, bar);
            __builtin_amdgcn_fence(__ATOMIC_ACQUIRE, "agent");
            asm volatile("s_waitcnt vmcnt(0)" ::: "memory");
        }
    }
    __syncthreads();
}

constexpr int N_PHASES = 15;

DEV void run_phase(const Params& p, int ph, unsigned char* smem) {
    unsigned char* ws = p.ws;
    float* SS = (float*)(ws + OFF_SS);
    const int G = gridDim.x, bid = blockIdx.x;
#ifdef PHASE_MASK
    if (!((PHASE_MASK >> ph) & 1)) return;
#endif
    switch (ph) {
    case 0: phase_prologue(p, smem); break;
    case 1: {
        EpiInProj e{SS, p.in[IN_A_Q_NORM], p.in[IN_A_KSLC_NORM], p.in[IN_A_KWIN_NORM], (bf16_t*)(ws + OFF_PROJ), (bf16_t*)(ws + OFF_VSLT), (bf16_t*)(ws + OFF_VWT), (float*)(ws + OFF_GATES), smem};
        for (int tl = bid; tl < 128 * 21; tl += G) gemm_tile(RowLin{XBLD}, (const bf16_t*)(ws + OFF_XB), 64, (const bf16_t*)(ws + OFF_WT_IN), 1024, tl / 21, tl % 21, e, smem);
    } break;
    case 2: {
        if (G == 512) {
            trans_range(p, NJOBS_L0, 13, 256, (float*)smem);
            for (int tl = bid; tl < 256; tl += G) {
                const int ks = tl & 1, which = (tl >> 1) >> 6, r = (tl >> 1) & 63;
                EpiCmp1P e{(float*)(ws + OFF_OBUF) + (size_t)(ks * 2 + which) * 4096 * 256};
                gemm_tile(RowCmp{which ? 1280 : 1024}, (const bf16_t*)(ws + OFF_PROJ) + (long)ks * 16 * 2048, 2048,
                          (const bf16_t*)(ws + (which ? OFF_WT_C1V : OFF_WT_C1K)) + ks * 1024, 1024, r >> 1, r & 1, e, smem, 2048 + 64);
            }
        } else {
            trans_range(p, NJOBS_L0, p.njobs, 0, (float*)smem);
            for (int tl = bid; tl < 128; tl += G) {
                const int which = tl >> 6, r = tl & 63;
                EpiCmp1 e{(const float*)(ws + OFF_B1) + which * 256, (bf16_t*)(ws + OFF_HID) + (size_t)which * 4096 * 256};
                gemm_tile(RowCmp{which ? 1280 : 1024}, (const bf16_t*)(ws + OFF_PROJ), 2048, (const bf16_t*)(ws + (which ? OFF_WT_C1V : OFF_WT_C1K)), 2048, r >> 1, r & 1, e, smem);
            }
        }
    } break;
    case 3: {
        if (G == 512) trans_range(p, 13, p.njobs, 64, (float*)smem);
        for (int tl = bid; tl < 64; tl += G) {
            const int which = tl >> 5, r = tl & 31;
            bf16_t* hid = (bf16_t*)(ws + OFF_HID) + (size_t)which * 4096 * 256;
            if (G == 512) {
                const float* p0 = (const float*)(ws + OFF_OBUF) + (size_t)which * 4096 * 256;
                const float* p1 = p0 + (size_t)2 * 4096 * 256;
                const float* b1 = (const float*)(ws + OFF_B1) + which * 256;
                const int c4 = (threadIdx.x & 63) * 4;
                const f32x4 bv = *(const f32x4*)(b1 + c4);
                for (int i = 0; i < 32; ++i) {
                    const long off = (long)(r * 128 + (threadIdx.x >> 6) + 4 * i) * 256 + c4;
                    f32x4 v = *(const f32x4*)(p0 + off) + *(const f32x4*)(p1 + off) + bv;
#pragma unroll
                    for (int q = 0; q < 4; ++q) { const float x = v[q]; const float u = 0.7978845608028654f * (x + 0.044715f * x * x * x); v[q] = x * sigmoidf_(2.f * u); }
                    st_bf16x4(hid + off, v);
                }
                asm volatile("s_waitcnt vmcnt(0)" ::: "memory");
                __syncthreads();
            }
            EpiCmp2 e{which, p.in[IN_A_KCMP_NORM], (bf16_t*)(ws + OFF_KCMP), (bf16_t*)(ws + OFF_VCMPT)};
            gemm_tile(RowLin{256}, hid, 64, (const bf16_t*)(ws + (which ? OFF_WT_C2V : OFF_WT_C2K)), 256, r, 0, e, smem);
        }
    } break;
    case 4: phase_nsa(p, smem); break;
    case 5: case 12: {
        const bool l0 = ph == 5;
        EpiResid e{l0 ? p.in[IN_X] : p.out, p.out, (bf16_t*)(ws + OFF_XB), SS + (l0 ? 1 : 3) * M};
        const bf16_t* wt = (const bf16_t*)(ws + (l0 ? OFF_WT_OUT0 : OFF_WT_OUT1));
        for (int tl = bid; tl < 128 * 8; tl += G) gemm_tile(RowLin{OBLD}, (const bf16_t*)(ws + OFF_OBUF), 64, wt, 1024, tl >> 3, tl & 7, e, smem);
    } break;
    case 6: case 13: {
        const bool l0 = ph == 6;
        EpiGateUp e{SS + (l0 ? 1 : 3) * M, (bf16_t*)(ws + OFF_HBUF)};
        const bf16_t* wt = (const bf16_t*)(ws + (l0 ? OFF_WT_GU0 : OFF_WT_GU1));
        for (int tl = bid; tl < 128 * 44; tl += G) gemm_tile(RowLin{XBLD}, (const bf16_t*)(ws + OFF_XB), 64, wt, 1024, tl / 44, tl % 44, e, smem);
    } break;
    case 7: case 14: {
        const bool l0 = ph == 7;
        EpiResid e{p.out, p.out, (bf16_t*)(ws + OFF_XB), l0 ? SS + 2 * M : (float*)nullptr};
        const bf16_t* wt = (const bf16_t*)(ws + (l0 ? OFF_WT_DN0 : OFF_WT_DN1));
        for (int tl = bid; tl < 128 * 8; tl += G) gemm_tile(RowLin{2816}, (const bf16_t*)(ws + OFF_HBUF), 64, wt, 2816, tl >> 3, tl & 7, e, smem);
    } break;
    case 8: {
        EpiKvqa e{SS + 2 * M, (bf16_t*)(ws + OFF_KVA), SS + 4 * M, SS + 5 * M};
        for (int tl = bid; tl < 128 * 6; tl += G) gemm_tile(RowLin{XBLD}, (const bf16_t*)(ws + OFF_XB), 64, (const bf16_t*)(ws + OFF_WT_KVQA), 1024, tl / 6, tl % 6, e, smem);
    } break;
    case 9: {
        EpiKvb ek{SS + 4 * M, (bf16_t*)(ws + OFF_K), (bf16_t*)(ws + OFF_VT), smem};
        EpiQb eq{SS + 5 * M, (bf16_t*)(ws + OFF_Q)};
        for (int tl = bid; tl < 128 * 16 + 128 * 12; tl += G) {
            if (tl < 2048) gemm_tile(RowLin{768}, (const bf16_t*)(ws + OFF_KVA), 64, (const bf16_t*)(ws + OFF_WT_KVB), 256, tl >> 4, tl & 15, ek, smem);
            else { const int u = tl - 2048; gemm_tile(RowLin{768}, (const bf16_t*)(ws + OFF_KVA) + 320, 64, (const bf16_t*)(ws + OFF_WT_QB), 384, u / 12, u % 12, eq, smem); }
        }
    } break;
    case 10: phase_finish(p); break;
    case 11: phase_mla(p, smem); break;
    default: break;
    }
}

__global__ void __launch_bounds__(256, 2) fwd_kernel(Params p) {
    __shared__ __attribute__((aligned(16))) unsigned char smem[65536];
#if COOP
    cg::grid_group grid = cg::this_grid();
    __shared__ uint4 xb_words;
    if (threadIdx.x == 0) xb_words = make_uint4(0u, 0u, 0u, 0u);
    __syncthreads();
    const XcdBarrier xb = xcd_barrier_post((unsigned*)(p.ws + OFF_BAR), (volatile LAS unsigned*)&xb_words);
    if (p.ph0 != 0) grid.sync();
    run_phase(p, 0, smem); xcd_barrier(xb);
    run_phase(p, 1, smem); xcd_barrier(xb);
    run_phase(p, 2, smem); xcd_barrier(xb);
    run_phase(p, 3, smem); xcd_barrier(xb);
    run_phase(p, 4, smem); xcd_barrier(xb);
    run_phase(p, 5, smem); xcd_barrier(xb);
    run_phase(p, 6, smem); xcd_barrier(xb);
    run_phase(p, 7, smem); xcd_barrier(xb);
    run_phase(p, 8, smem); xcd_barrier(xb);
    run_phase(p, 9, smem); xcd_barrier(xb);
    run_phase(p, 10, smem); xcd_barrier(xb);
    run_phase(p, 11, smem); xcd_barrier(xb);
    run_phase(p, 12, smem); xcd_barrier(xb);
    run_phase(p, 13, smem); xcd_barrier(xb);
    run_phase(p, 14, smem);
#else
    run_phase(p, p.ph0, smem);
#endif
}

static void add_job(Params& p, const float* src, const float* gain, size_t dst_off, int dst_row0, int K, int ldsrc, int nvalid, int nchunks, int mode) {
    TJob& j = p.jobs[p.njobs++];
    j.src = src; j.gain = gain; j.dst = (bf16_t*)(p.ws + dst_off) + (size_t)dst_row0 * (K + 64); j.ldd = K + 64; j.K = K; j.ldsrc = ldsrc; j.nvalid = nvalid; j.nchunks = nchunks; j.mode = mode; j.tile0 = p.ntrans;
    p.ntrans += (K / 64) * ((nchunks + 3) / 4);
}

extern "C" void kernel_launch(void* const* d_in, const int* in_sizes, int n_in, void* d_out, int out_size, void* d_ws, size_t ws_size, hipStream_t stream) {
    Params p;
    memset(&p, 0, sizeof(p));
    for (int i = 0; i < N_IN; ++i) p.in[i] = (const float*)d_in[i];
    p.out = (float*)d_out; p.ws = (unsigned char*)d_ws;
    if (ws_size < WS_NEED) { fprintf(stderr, "workspace too small: %zu < %zu\n", ws_size, (size_t)WS_NEED); return; }
    const float* ffn_norm = p.in[IN_FFN_NORM]; const float* wgu = p.in[IN_FFN_W_GU]; const float* wdn = p.in[IN_FFN_W_DN];
    add_job(p, p.in[IN_A_W_IN], p.in[IN_A_ATTN_NORM], OFF_WT_IN, 0, 1024, 2608, 2608, 84, 0);
    add_job(p, p.in[IN_K_W1], nullptr, OFF_WT_C1K, 0, 2048, 256, 256, 8, 0);
    add_job(p, p.in[IN_V_W1], nullptr, OFF_WT_C1V, 0, 2048, 256, 256, 8, 0);
    add_job(p, p.in[IN_K_W2], nullptr, OFF_WT_C2K, 0, 256, 64, 64, 4, 0);
    add_job(p, p.in[IN_V_W2], nullptr, OFF_WT_C2V, 0, 256, 64, 64, 4, 0);
    add_job(p, p.in[IN_A_W_OUT], nullptr, OFF_WT_OUT0, 0, 1024, 1024, 1024, 32, 0);
    add_job(p, wgu, ffn_norm, OFF_WT_GU0, 0, 1024, 5632, 5632, 176, 1);
    add_job(p, wdn, nullptr, OFF_WT_DN0, 0, 2816, 1024, 1024, 32, 0);
    add_job(p, p.in[IN_KV_W_A], p.in[IN_KV_NORM], OFF_WT_KVQA, 0, 1024, 320, 320, 10, 0);
    add_job(p, p.in[IN_B_W_Q_A], p.in[IN_B_ATTN_NORM], OFF_WT_KVQA, 320, 1024, 384, 384, 14, 0);
    add_job(p, p.in[IN_KV_W_B], p.in[IN_KV_C_NORM], OFF_WT_KVB, 0, 256, 2048, 2048, 64, 0);
    add_job(p, p.in[IN_B_W_Q_B], p.in[IN_B_Q_A_NORM], OFF_WT_QB, 0, 384, 1536, 1536, 48, 0);
    add_job(p, p.in[IN_B_W_OUT], nullptr, OFF_WT_OUT1, 0, 1024, 1024, 1024, 32, 0);
    add_job(p, wgu + (size_t)1024 * 5632, ffn_norm + 1024, OFF_WT_GU1, 0, 1024, 5632, 5632, 176, 1);
    add_job(p, wdn + (size_t)2816 * 1024, nullptr, OFF_WT_DN1, 0, 2816, 1024, 1024, 32, 0);
    static int grid = 0;
    if (!grid) {
        int dev = 0, cus = 0, per_cu = 0;
        hipGetDevice(&dev);
        hipDeviceGetAttribute(&cus, hipDeviceAttributeMultiprocessorCount, dev);
        hipOccupancyMaxActiveBlocksPerMultiprocessor(&per_cu, fwd_kernel, 256, 0);
        if (per_cu > 2) per_cu = 2;
        if (per_cu < 1) per_cu = 1;
        if (cus <= 0) cus = 256;
        grid = cus * per_cu;
    }
#if COOP
    p.ph0 = 0; p.ph1 = N_PHASES;
    hipMemsetAsync(p.ws + OFF_BAR, 0, XCD_BAR_WORDS * 4, stream);
    void* args[] = {&p};
    hipError_t e = hipLaunchCooperativeKernel((void*)fwd_kernel, dim3(grid), dim3(256), args, 0, stream);
    if (e != hipSuccess) fprintf(stderr, "cooperative launch failed: %s\n", hipGetErrorString(e));
#else
    for (int ph = 0; ph < N_PHASES; ++ph) {
        p.ph0 = ph; p.ph1 = ph + 1;
#ifdef DUP_PHASE
        if (ph == DUP_PHASE) { p.abl = DUP_ABL; for (int rep = 0; rep < DUP_REPS; ++rep) fwd_kernel<<<grid, 256, 0, stream>>>(p); p.abl = 0; }
#endif
        fwd_kernel<<<grid, 256, 0, stream>>>(p);
    }
#endif
}
```

```cpp
#include <hip/hip_runtime.h>
#include <hip/hip_cooperative_groups.h>
#include <stdint.h>
#include <string.h>
#include <stdio.h>
namespace cg = cooperative_groups;

#ifndef COOP
#define COOP 1
#endif

typedef unsigned short bf16_t;
typedef short bf16x8 __attribute__((ext_vector_type(8)));
typedef float f32x4 __attribute__((ext_vector_type(4)));
typedef unsigned u32x4 __attribute__((ext_vector_type(4)));
typedef unsigned u32x2 __attribute__((ext_vector_type(2)));
typedef unsigned long long u64;
#define DEV __device__ __forceinline__

constexpr int T = 8192, M = 16384;
constexpr float EPS = 1e-6f;
constexpr float LOG2E = 1.4426950408889634f;
constexpr float QSCALE_NSA = 0.125f * LOG2E;
constexpr float QSCALE_MLA = 0.07216878364870322f * LOG2E;

enum { IN_X = 0, IN_A_ATTN_NORM, IN_A_W_IN, IN_A_Q_NORM, IN_A_KCMP_NORM, IN_A_KSLC_NORM, IN_A_KWIN_NORM, IN_POS_K, IN_POS_V,
       IN_K_W1, IN_K_B1, IN_K_W2, IN_V_W1, IN_V_B1, IN_V_W2, IN_A_W_OUT, IN_KV_NORM, IN_KV_W_A, IN_KV_C_NORM, IN_KV_W_B, IN_KV_K_NORM,
       IN_B_ATTN_NORM, IN_B_W_Q_A, IN_B_Q_A_NORM, IN_B_W_Q_B, IN_B_Q_NORM, IN_B_W_OUT, IN_FFN_NORM, IN_FFN_W_GU, IN_FFN_W_DN, N_IN };

constexpr size_t OFF_WT_IN = 0;
constexpr size_t OFF_WT_C1K = OFF_WT_IN + (size_t)2688 * 1088 * 2;
constexpr size_t OFF_WT_C1V = OFF_WT_C1K + (size_t)256 * 2112 * 2;
constexpr size_t OFF_WT_C2K = OFF_WT_C1V + (size_t)256 * 2112 * 2;
constexpr size_t OFF_WT_C2V = OFF_WT_C2K + (size_t)128 * 320 * 2;
constexpr size_t OFF_WT_OUT0 = OFF_WT_C2V + (size_t)128 * 320 * 2;
constexpr size_t OFF_WT_GU0 = OFF_WT_OUT0 + (size_t)1024 * 1088 * 2;
constexpr size_t OFF_WT_DN0 = OFF_WT_GU0 + (size_t)5632 * 1088 * 2;
constexpr size_t OFF_WT_KVQA = OFF_WT_DN0 + (size_t)1024 * 2880 * 2;
constexpr size_t OFF_WT_KVB = OFF_WT_KVQA + (size_t)768 * 1088 * 2;
constexpr size_t OFF_WT_QB = OFF_WT_KVB + (size_t)2048 * 320 * 2;
constexpr size_t OFF_WT_OUT1 = OFF_WT_QB + (size_t)1536 * 448 * 2;
constexpr size_t OFF_WT_GU1 = OFF_WT_OUT1 + (size_t)1024 * 1088 * 2;
constexpr size_t OFF_WT_DN1 = OFF_WT_GU1 + (size_t)5632 * 1088 * 2;
constexpr size_t OFF_B1 = OFF_WT_DN1 + (size_t)1024 * 2880 * 2;
constexpr size_t OFF_SS = OFF_B1 + 2048;
constexpr size_t OFF_GATES = OFF_SS + (size_t)6 * M * 4;
constexpr size_t OFF_HID = OFF_GATES + (size_t)M * 48 * 4;
constexpr size_t OFF_KCMP = OFF_HID + (size_t)2 * 4096 * 256 * 2;
constexpr size_t OFF_VCMPT = OFF_KCMP + (size_t)8 * 512 * 64 * 2;
constexpr size_t OFF_XB = OFF_VCMPT + (size_t)8 * 64 * 512 * 2;
constexpr int XBLD = 1088, OBLD = 1088;
constexpr size_t OFF_OBUF = OFF_XB + (size_t)M * XBLD * 2;
constexpr size_t OFF_A = OFF_OBUF + (size_t)M * OBLD * 2;
constexpr size_t OFF_PROJ = OFF_A;
constexpr size_t OFF_VSLT = OFF_PROJ + (size_t)M * 2048 * 2;
constexpr size_t OFF_VWT = OFF_VSLT + (size_t)8 * 64 * T * 2;
constexpr size_t OFF_HBUF = OFF_A;
constexpr size_t OFF_K = OFF_A;
constexpr size_t OFF_Q = OFF_K + (size_t)M * 1536 * 2;
constexpr size_t OFF_VT = OFF_XB;
constexpr size_t OFF_KVA = OFF_OBUF;
constexpr size_t OFF_BAR = OFF_Q + (size_t)M * 1536 * 2;
constexpr size_t WS_NEED = OFF_BAR + 16384;
static_assert(WS_NEED <= (size_t)256 * 1024 * 1024, "workspace layout exceeds 256 MiB");

struct TJob { const float* src; const float* gain; bf16_t* dst; int K, ldsrc, nvalid, nchunks, mode, tile0, ldd, pad; };
struct Params {
    const float* in[N_IN];
    float* out;
    unsigned char* ws;
    TJob jobs[16];
    int njobs, ntrans, ph0, ph1, abl, pad;
};

typedef float f32x2_ __attribute__((ext_vector_type(2)));
typedef __bf16 bf16x2_ __attribute__((ext_vector_type(2)));
DEV unsigned pk_bf16(float lo, float hi) { const f32x2_ v = {lo, hi}; return __builtin_bit_cast(unsigned, __builtin_convertvector(v, bf16x2_)); }
DEV int otid() { int t = threadIdx.x; asm volatile("" : "+v"(t)); return t; }
DEV float bf2f(bf16_t h) { return __uint_as_float((unsigned)h << 16); }
DEV bf16_t f2bf(float f) { return (bf16_t)(pk_bf16(f, 0.f) & 0xffffu); }
DEV void st_bf16x4(bf16_t* p, f32x4 v) { u32x2 u; u.x = pk_bf16(v[0], v[1]); u.y = pk_bf16(v[2], v[3]); *(u32x2*)p = u; }
DEV float quad_sum(float v) {
    u32x2 r = __builtin_amdgcn_permlane16_swap(__float_as_uint(v), __float_as_uint(v), false, false);
    v = __uint_as_float(r.x) + __uint_as_float(r.y);
    r = __builtin_amdgcn_permlane32_swap(__float_as_uint(v), __float_as_uint(v), false, false);
    return __uint_as_float(r.x) + __uint_as_float(r.y);
}
DEV float quad_max(float v) {
    u32x2 r = __builtin_amdgcn_permlane16_swap(__float_as_uint(v), __float_as_uint(v), false, false);
    v = fmaxf(__uint_as_float(r.x), __uint_as_float(r.y));
    r = __builtin_amdgcn_permlane32_swap(__float_as_uint(v), __float_as_uint(v), false, false);
    return fmaxf(__uint_as_float(r.x), __uint_as_float(r.y));
}
#define DPP_ADD(v, ctrl) (v) += __uint_as_float((unsigned)__builtin_amdgcn_update_dpp(0, (int)__float_as_uint(v), (ctrl), 0xF, 0xF, true))
DEV float wave_sum(float v) {
    DPP_ADD(v, 0xB1); DPP_ADD(v, 0x4E); DPP_ADD(v, 0x141); DPP_ADD(v, 0x140);
    return quad_sum(v);
}
DEV float fexp2(float x) { return __builtin_amdgcn_exp2f(x); }
DEV float sigmoidf_(float x) { return 1.f / (1.f + __expf(-x)); }
DEV f32x4 mfma16(bf16x8 a, bf16x8 b, f32x4 c) { return __builtin_amdgcn_mfma_f32_16x16x32_bf16(a, b, c, 0, 0, 0); }
DEV int take_bit(u64& lo, u64& hi) {
    const bool uselo = lo != 0ull;
    const u64 v = uselo ? lo : hi;
    if (v == 0ull) return -1;
    const int b = __builtin_ctzll(v);
    const u64 nv = v & (v - 1ull);
    lo = uselo ? nv : lo; hi = uselo ? hi : nv;
    return b + (uselo ? 0 : 64);
}
DEV u64 uni64(u64 v) { unsigned lo = __builtin_amdgcn_readfirstlane((unsigned)v), hi = __builtin_amdgcn_readfirstlane((unsigned)(v >> 32)); return ((u64)hi << 32) | lo; }

DEV void trans_tile(const TJob& jb, int lt, float* tl) {
    const int nk = jb.K >> 6, kt = lt % nk, sc = lt / nk, tid = threadIdx.x;
    float4 v[4][2];
#pragma unroll
    for (int c = 0; c < 4; ++c) {
        const int ch = sc * 4 + c;
        const int col0 = (jb.mode == 1) ? ((ch & 1) * 2816 + (ch >> 2) * 64 + ((ch >> 1) & 1) * 32) : ch * 32;
#pragma unroll
        for (int i = 0; i < 2; ++i) {
            const int idx = tid + i * 256, k = idx >> 3, col = col0 + (idx & 7) * 4;
            v[c][i] = make_float4(0.f, 0.f, 0.f, 0.f);
            if (ch < jb.nchunks && col < jb.nvalid) v[c][i] = *(const float4*)(jb.src + (size_t)(kt * 64 + k) * jb.ldsrc + col);
        }
    }
#pragma unroll
    for (int i = 0; i < 2; ++i) {
        const int idx = tid + i * 256, k = idx >> 3, c4 = (idx & 7) * 4;
        const float gn = jb.gain ? jb.gain[kt * 64 + k] : 1.f;
#pragma unroll
        for (int c = 0; c < 4; ++c) {
            float* t_ = tl + c * (64 * 33) + k * 33 + c4;
            t_[0] = v[c][i].x * gn; t_[1] = v[c][i].y * gn; t_[2] = v[c][i].z * gn; t_[3] = v[c][i].w * gn;
        }
    }
    __syncthreads();
    {
        const int n = tid >> 3, k8 = (tid & 7) * 8;
#pragma unroll
        for (int c = 0; c < 4; ++c) {
            const int ch = sc * 4 + c;
            if (ch < jb.nchunks) {
                const float* t_ = tl + c * (64 * 33) + n;
                u32x4 o;
                o.x = pk_bf16(t_[(k8 + 0) * 33], t_[(k8 + 1) * 33]); o.y = pk_bf16(t_[(k8 + 2) * 33], t_[(k8 + 3) * 33]);
                o.z = pk_bf16(t_[(k8 + 4) * 33], t_[(k8 + 5) * 33]); o.w = pk_bf16(t_[(k8 + 6) * 33], t_[(k8 + 7) * 33]);
                *(u32x4*)(jb.dst + (size_t)(ch * 32 + n) * jb.ldd + kt * 64 + k8) = o;
            }
        }
    }
    __syncthreads();
}

DEV void trans_range(const Params& p, int j0, int j1, int b0, float* tl) {
    const int t0 = p.jobs[j0].tile0, t1 = (j1 < p.njobs) ? p.jobs[j1].tile0 : p.ntrans;
    if ((int)blockIdx.x < b0) return;
    for (int it = t0 + (int)blockIdx.x - b0; it < t1; it += gridDim.x - b0) {
        int j = j0;
        while (j + 1 < j1 && it >= p.jobs[j + 1].tile0) ++j;
        trans_tile(p.jobs[j], it - p.jobs[j].tile0, tl);
    }
}

constexpr int NJOBS_L0 = 8;

DEV void phase_prologue(const Params& p, unsigned char* smem) {
    float* tl = (float*)smem;
    const int tid = threadIdx.x;
    trans_range(p, 0, NJOBS_L0, 0, tl);
    if (blockIdx.x < 32) {
        const int which = blockIdx.x >> 4, col = (blockIdx.x & 15) * 16 + (tid & 15), kl = tid >> 4;
        const float* w1 = p.in[which ? IN_V_W1 : IN_K_W1];
        const float* pe = p.in[which ? IN_POS_V : IN_POS_K];
        const float* b1 = p.in[which ? IN_V_B1 : IN_K_B1];
        float a = 0.f;
#pragma unroll 8
        for (int k = kl; k < 2048; k += 16) a += pe[k] * w1[(size_t)k * 256 + col];
        a += __shfl_xor(a, 16); a += __shfl_xor(a, 32);
        float* red = (float*)smem;
        __syncthreads();
        if ((tid & 63) < 16) red[(tid >> 6) * 16 + (tid & 15)] = a;
        __syncthreads();
        if (tid < 16) ((float*)(p.ws + OFF_B1))[which * 256 + col] = b1[col] + ((red[tid] + red[16 + tid]) + (red[32 + tid] + red[48 + tid]));
        __syncthreads();
    }
    {
        const float* x = p.in[IN_X];
        bf16_t* xb = (bf16_t*)(p.ws + OFF_XB);
        float* ss = (float*)(p.ws + OFF_SS);
        const int lane = tid & 63;
        for (int row = (blockIdx.x * 4 + (tid >> 6)) * 2; row < M; row += gridDim.x * 8) {
            float4 v[2][4];
#pragma unroll
            for (int r = 0; r < 2; ++r)
#pragma unroll
                for (int i = 0; i < 4; ++i) v[r][i] = *(const float4*)(x + (size_t)(row + r) * 1024 + i * 256 + lane * 4);
#pragma unroll
            for (int r = 0; r < 2; ++r) {
                float s_ = 0.f;
#pragma unroll
                for (int i = 0; i < 4; ++i) {
                    s_ += v[r][i].x * v[r][i].x + v[r][i].y * v[r][i].y + v[r][i].z * v[r][i].z + v[r][i].w * v[r][i].w;
                    st_bf16x4(xb + (size_t)(row + r) * XBLD + i * 256 + lane * 4, (f32x4){v[r][i].x, v[r][i].y, v[r][i].z, v[r][i].w});
                }
                s_ = wave_sum(s_);
                if (lane == 0) ss[row + r] = s_;
            }
        }
        for (int i = blockIdx.x * 256 + tid; i < 5 * M; i += gridDim.x * 256) ss[M + i] = 0.f;
    }
}

#define LAS __attribute__((address_space(3)))
#define RAW_BARRIER() do { asm volatile("s_waitcnt lgkmcnt(0)" ::: "memory"); __builtin_amdgcn_s_barrier(); asm volatile("" ::: "memory"); } while (0)
DEV void glds16_asm(const void* gsrc, unsigned lds_dst) {
    asm volatile("s_mov_b32 m0, %1\n\ts_nop 0\n\tglobal_load_lds_dwordx4 %0, off" :: "v"(gsrc), "s"(lds_dst) : "m0", "memory");
}


struct RowLin { long lda; DEV long operator()(int r) const { return (long)r * lda; } };
struct RowCmp { int colbase; DEV long operator()(int r) const { const int bg = r >> 9; int j = r & 511; if (j > 510) j = 510;
    return ((long)((bg >> 2) * T + 16 * j)) * 2048 + colbase + (bg & 3) * 64; } };

DEV void glds16_s(const void* sbase, unsigned voff, unsigned lds_dst) {
    asm volatile("s_mov_b32 m0, %2\n\ts_nop 0\n\tglobal_load_lds_dwordx4 %0, %1" :: "v"(voff), "s"(sbase), "s"(lds_dst) : "m0", "memory");
}

template <class RowMap, class Epi>
DEV void gemm_tile(const RowMap& rm, const bf16_t* __restrict__ A, long a_kstep, const bf16_t* __restrict__ Bt, int K, int tm, int tn, const Epi& epi, unsigned char* smem) {
    const int tid = threadIdx.x, lane = tid & 63, w = tid >> 6, wm = w >> 1, wn = w & 1, fr = lane & 15, fq = lane >> 4;
    const bf16_t* As = (const bf16_t*)smem;
    const size_t ldb_ = (size_t)K + 64;
    unsigned aoff[4], boff[4];
#pragma unroll
    for (int i = 0; i < 4; ++i) {
        const int row = 8 * (4 * w + i) + (lane >> 3), c = (lane & 7) ^ ((4 * i + (lane >> 4)) & 7);
        aoff[i] = (unsigned)((rm(tm * 128 + row) + c * 8) * 2);
        boff[i] = (unsigned)(((size_t)(tn * 128 + row) * ldb_ + c * 8) * 2);
    }
    const unsigned lds_u = (unsigned)(unsigned long long)(LAS unsigned char*)smem + (unsigned)(4 * w) * 1024u;
    unsigned la[2][4];
#pragma unroll
    for (int b_ = 0; b_ < 2; ++b_)
#pragma unroll
        for (int i = 0; i < 4; ++i) la[b_][i] = (unsigned)__builtin_amdgcn_readfirstlane((int)(lds_u + (unsigned)b_ * 32768u + (unsigned)i * 1024u));
#define GEMM_ISSUE(kt_, buf_) do { const bf16_t* ab_ = A + (long)(kt_) * a_kstep; const bf16_t* bb_ = Bt + (long)(kt_) * 64; \
        _Pragma("unroll") for (int i_ = 0; i_ < 4; ++i_) { glds16_s(ab_, aoff[i_], la[buf_][i_]); glds16_s(bb_, boff[i_], la[buf_][i_] + 16384u); } } while (0)
#define GEMM_ISSUE1(kt_, buf_, i_) do { glds16_s(A + (long)(kt_) * a_kstep, aoff[i_], la[buf_][i_]); glds16_s(Bt + (long)(kt_) * 64, boff[i_], la[buf_][i_] + 16384u); } while (0)
    f32x4 acc[4][4];
#pragma unroll
    for (int a = 0; a < 4; ++a)
#pragma unroll
        for (int b = 0; b < 4; ++b) acc[a][b] = (f32x4){0.f, 0.f, 0.f, 0.f};
    const int nk = K >> 6;
    const int fsw = (fr >> 1) & 7;
    __syncthreads();
    GEMM_ISSUE(0, 0);
    for (int kt = 0; kt < nk; ++kt) {
        asm volatile("s_waitcnt vmcnt(0)" ::: "memory");
        RAW_BARRIER();
        const bool nxt = kt + 1 < nk;
        const int bo = (kt & 1) * 16384;
#pragma unroll
        for (int ks = 0; ks < 2; ++ks) {
            bf16x8 af[4], bfr[4];
#pragma unroll
            for (int i = 0; i < 4; ++i) { af[i] = *(const bf16x8*)(As + bo + (wm * 64 + i * 16 + fr) * 64 + (((ks * 4 + fq) ^ fsw) * 8)); bfr[i] = *(const bf16x8*)(As + bo + 8192 + (wn * 64 + i * 16 + fr) * 64 + (((ks * 4 + fq) ^ fsw) * 8)); }
#pragma unroll
            for (int mi = 0; mi < 4; ++mi) {
#pragma unroll
                for (int ni = 0; ni < 4; ++ni) acc[mi][ni] = mfma16(bfr[ni], af[mi], acc[mi][ni]);
                if (ks == 0 && nxt) { if (kt & 1) GEMM_ISSUE1(kt + 1, 0, mi); else GEMM_ISSUE1(kt + 1, 1, mi); }
            }
        }
    }
#undef GEMM_ISSUE
#undef GEMM_ISSUE1
    epi(acc, tm * 128 + wm * 64, tn * 128 + wn * 64, fr, fq);
}

template <class Epi>
DEV void gemm_tile_big(long lda, const bf16_t* __restrict__ A, const bf16_t* __restrict__ Bt, int K, int tm, int tn, const Epi& epi, unsigned char* smem) {
    bf16_t* As = (bf16_t*)smem; bf16_t* Bs = As + 256 * 64;
    const int tid = threadIdx.x, lane = tid & 63, w = tid >> 6, wm = w >> 1, wn = w & 1, fr = lane & 15, fq = lane >> 4;
    const int c0_ = (tid & 7) * 8;
    const bf16_t* const ap0 = A + (long)(tm * 256 + (tid >> 3)) * lda + c0_;
    const long astep = 32 * lda;
    const size_t ldb_ = (size_t)K + 64;
    const bf16_t* const bp0 = Bt + (size_t)(tn * 128 + (tid >> 3)) * ldb_ + c0_;
    const size_t bstep = 32 * ldb_;
    f32x4 acc[2][4][4];
#pragma unroll
    for (int h = 0; h < 2; ++h)
#pragma unroll
        for (int a = 0; a < 4; ++a)
#pragma unroll
            for (int b = 0; b < 4; ++b) acc[h][a][b] = (f32x4){0.f, 0.f, 0.f, 0.f};
    u32x4 ra[8], rb[4];
    const int nk = K >> 6;
    const int sto = (tid >> 3) * 64 + (((tid & 7) ^ ((tid >> 4) & 7)) * 8);
    const int fsw = (fr >> 1) & 7;
#pragma unroll
    for (int i = 0; i < 8; ++i) ra[i] = *(const u32x4*)(ap0 + i * astep);
#pragma unroll
    for (int i = 0; i < 4; ++i) rb[i] = *(const u32x4*)(bp0 + i * bstep);
    for (int kt = 0; kt < nk; ++kt) {
        __syncthreads();
#pragma unroll
        for (int i = 0; i < 8; ++i) *(u32x4*)(As + sto + i * 32 * 64) = ra[i];
#pragma unroll
        for (int i = 0; i < 4; ++i) *(u32x4*)(Bs + sto + i * 32 * 64) = rb[i];
        __syncthreads();
        if (kt + 1 < nk) {
#pragma unroll
            for (int i = 0; i < 8; ++i) ra[i] = *(const u32x4*)(ap0 + i * astep + (kt + 1) * 64);
#pragma unroll
            for (int i = 0; i < 4; ++i) rb[i] = *(const u32x4*)(bp0 + i * bstep + (kt + 1) * 64);
        }
#pragma unroll
        for (int ks = 0; ks < 2; ++ks) {
            bf16x8 bfr[4];
#pragma unroll
            for (int i = 0; i < 4; ++i) bfr[i] = *(const bf16x8*)(Bs + (wn * 64 + i * 16 + fr) * 64 + (((ks * 4 + fq) ^ fsw) * 8));
#pragma unroll
            for (int h = 0; h < 2; ++h) {
                bf16x8 af[4];
#pragma unroll
                for (int i = 0; i < 4; ++i) af[i] = *(const bf16x8*)(As + (wm * 128 + h * 64 + i * 16 + fr) * 64 + (((ks * 4 + fq) ^ fsw) * 8));
#pragma unroll
                for (int mi = 0; mi < 4; ++mi)
#pragma unroll
                    for (int ni = 0; ni < 4; ++ni) acc[h][mi][ni] = mfma16(bfr[ni], af[mi], acc[h][mi][ni]);

            }
        }
    }
    epi(acc[0], tm * 256 + wm * 128, tn * 128 + wn * 64, fr, fq);
    epi(acc[1], tm * 256 + wm * 128 + 64, tn * 128 + wn * 64, fr, fq);
}

DEV void store_vt_tile(const f32x4 (&acc)[4][4], const float (&sc)[4], bf16_t* dst, long ldt, unsigned char* smem, int fr, int fq) {
    __syncthreads();
    bf16_t* L = (bf16_t*)smem + (threadIdx.x >> 6) * (64 * 72);
#pragma unroll
    for (int mi = 0; mi < 4; ++mi)
#pragma unroll
        for (int ni = 0; ni < 4; ++ni)
#pragma unroll
            for (int r = 0; r < 4; ++r) L[(ni * 16 + fq * 4 + r) * 72 + mi * 16 + fr] = f2bf(acc[mi][ni][r] * sc[mi]);
    const int lane = threadIdx.x & 63;
#pragma unroll
    for (int j = 0; j < 8; ++j) { const int q = lane + 64 * j, d = q >> 3, c = (q & 7) * 8; *(u32x4*)(dst + (long)d * ldt + c) = *(const u32x4*)(L + d * 72 + c); }
}

struct EpiInProj {
    const float* ss0; const float* qn; const float* kslcn; const float* kwinn; bf16_t* proj; bf16_t* vslt; bf16_t* vwt; float* gates; unsigned char* smem;
    DEV void operator()(f32x4 (&acc)[4][4], int row0, int col0, int fr, int fq) const {
        const int cb = col0 >> 6;
        if (cb >= 41) return;
#pragma unroll
        for (int mi = 0; mi < 4; ++mi) {
            const float rstd = rsqrtf(ss0[row0 + mi * 16 + fr] * (1.f / 1024.f) + EPS);
#pragma unroll
            for (int ni = 0; ni < 4; ++ni) acc[mi][ni] *= rstd;
        }
        const bool isq = cb < 16, isksl = (cb >= 24 && cb < 28), iskw = (cb >= 32 && cb < 36);
        if (isq || isksl || iskw) {
            const int dstcol = isq ? cb * 64 : (isksl ? 1536 + (cb - 24) * 64 : 1792 + (cb - 32) * 64);
            const float extra = isq ? QSCALE_NSA : 1.f;
#pragma unroll
            for (int mi = 0; mi < 4; ++mi) {
                float ss = 0.f;
#pragma unroll
                for (int ni = 0; ni < 4; ++ni) { const f32x4 v = acc[mi][ni]; ss += v[0] * v[0] + v[1] * v[1] + v[2] * v[2] + v[3] * v[3]; }
                ss = quad_sum(ss);
                const float r2 = rsqrtf(ss * (1.f / 64.f) + EPS) * extra;
                const long row = row0 + mi * 16 + fr;
#pragma unroll
                for (int ni = 0; ni < 4; ++ni) {
                    const f32x4 gq = *(const f32x4*)(qn + ni * 16 + fq * 4), gs = *(const f32x4*)(kslcn + ni * 16 + fq * 4), gw = *(const f32x4*)(kwinn + ni * 16 + fq * 4);
                    const f32x4 g4 = isq ? gq : (isksl ? gs : gw);
                    st_bf16x4(proj + row * 2048 + dstcol + ni * 16 + fq * 4, acc[mi][ni] * r2 * g4);
                }
            }
        } else if ((cb >= 16 && cb < 24)) {
            const int dstcol = 1024 + (cb - 16) * 64;
#pragma unroll
            for (int mi = 0; mi < 4; ++mi) { const long row = row0 + mi * 16 + fr;
#pragma unroll
                for (int ni = 0; ni < 4; ++ni) st_bf16x4(proj + row * 2048 + dstcol + ni * 16 + fq * 4, acc[mi][ni]); }
        } else if ((cb >= 28 && cb < 32) || (cb >= 36 && cb < 40)) {
            bf16_t* dst = cb < 32 ? vslt : vwt; const int g = cb < 32 ? cb - 28 : cb - 36;
            const int b = row0 >> 13, t0 = row0 & (T - 1);
            const float one4[4] = {1.f, 1.f, 1.f, 1.f};
            store_vt_tile(acc, one4, dst + ((long)((b * 4 + g) * 64)) * T + t0, T, smem, fr, fq);
        } else if (cb == 40) {
#pragma unroll
            for (int mi = 0; mi < 4; ++mi) { const long row = row0 + mi * 16 + fr;
#pragma unroll
                for (int ni = 0; ni < 3; ++ni) { f32x4 v = acc[mi][ni];
#pragma unroll
                    for (int r = 0; r < 4; ++r) v[r] = sigmoidf_(v[r]);
                    *(f32x4*)(gates + row * 48 + ni * 16 + fq * 4) = v; } }
        }
    }
};

struct EpiCmp1 {
    const float* b1; bf16_t* hid;
    DEV void operator()(f32x4 (&acc)[4][4], int row0, int col0, int fr, int fq) const {
#pragma unroll
        for (int ni = 0; ni < 4; ++ni) { const f32x4 bv = *(const f32x4*)(b1 + col0 + ni * 16 + fq * 4);
#pragma unroll
            for (int mi = 0; mi < 4; ++mi) { f32x4 v = acc[mi][ni] + bv;
#pragma unroll
                for (int r = 0; r < 4; ++r) { const float x = v[r]; const float u = 0.7978845608028654f * (x + 0.044715f * x * x * x); v[r] = x * sigmoidf_(2.f * u); }
                st_bf16x4(hid + (long)(row0 + mi * 16 + fr) * 256 + col0 + ni * 16 + fq * 4, v); } }
    }
};

struct EpiCmp2 {
    int which; const float* gain; bf16_t* kcmp; bf16_t* vcmpt;
    DEV void operator()(f32x4 (&acc)[4][4], int row0, int col0, int fr, int fq) const {
        if (col0 != 0) return;
        if (which == 0) {
#pragma unroll
            for (int mi = 0; mi < 4; ++mi) {
                float ss = 0.f;
#pragma unroll
                for (int ni = 0; ni < 4; ++ni) { const f32x4 v = acc[mi][ni]; ss += v[0] * v[0] + v[1] * v[1] + v[2] * v[2] + v[3] * v[3]; }
                ss = quad_sum(ss);
                const float r2 = rsqrtf(ss * (1.f / 64.f) + EPS);
                const long row = row0 + mi * 16 + fr;
#pragma unroll
                for (int ni = 0; ni < 4; ++ni) { const f32x4 g4 = *(const f32x4*)(gain + ni * 16 + fq * 4); st_bf16x4(kcmp + row * 64 + ni * 16 + fq * 4, acc[mi][ni] * r2 * g4); }
            }
        } else {
#pragma unroll
            for (int mi = 0; mi < 4; ++mi) { const int row = row0 + mi * 16 + fr, bg = row >> 9, j = row & 511;
#pragma unroll
                for (int ni = 0; ni < 4; ++ni)
#pragma unroll
                    for (int r = 0; r < 4; ++r) vcmpt[((long)(bg * 64 + ni * 16 + fq * 4 + r)) * 512 + j] = f2bf(acc[mi][ni][r]); }
        }
    }
};

struct EpiResid {
    const float* base; float* out; bf16_t* xb; float* ssn;
    DEV void operator()(f32x4 (&acc)[4][4], int row0, int col0, int fr, int fq) const {
#pragma unroll
        for (int mi = 0; mi < 4; ++mi) {
            const long row = row0 + mi * 16 + fr; float ss = 0.f;
#pragma unroll
            for (int ni = 0; ni < 4; ++ni) {
                const long off = row * 1024 + col0 + ni * 16 + fq * 4;
                const f32x4 v = *(const f32x4*)(base + off) + acc[mi][ni];
                *(f32x4*)(out + off) = v;
                if (ssn) { st_bf16x4(xb + row * XBLD + col0 + ni * 16 + fq * 4, v); ss += v[0] * v[0] + v[1] * v[1] + v[2] * v[2] + v[3] * v[3]; }
            }
            if (ssn) { ss = quad_sum(ss); if (fq == 0) atomicAdd(ssn + row, ss); }
        }
    }
};

struct EpiGateUp {
    const float* ss; bf16_t* hbuf;
    DEV void operator()(f32x4 (&acc)[4][4], int row0, int col0, int fr, int fq) const {
        const int hc0 = (col0 >> 7) * 64 + ((col0 >> 6) & 1) * 32;
#pragma unroll
        for (int mi = 0; mi < 4; ++mi) {
            const long row = row0 + mi * 16 + fr;
            const float rstd = rsqrtf(ss[row] * (1.f / 1024.f) + EPS);
#pragma unroll
            for (int ni = 0; ni < 2; ++ni) {
                f32x4 g = acc[mi][ni] * rstd, u = acc[mi][ni + 2] * rstd, h;
#pragma unroll
                for (int r = 0; r < 4; ++r) h[r] = g[r] * sigmoidf_(g[r]) * u[r];
                st_bf16x4(hbuf + row * 2816 + hc0 + ni * 16 + fq * 4, h);
            }
        }
    }
};

struct EpiKvqa {
    const float* ss; bf16_t* kva; float* ssc; float* ssq;
    DEV void operator()(f32x4 (&acc)[4][4], int row0, int col0, int fr, int fq) const {
        const int cb = col0 >> 6;
        if (cb >= 11) return;
#pragma unroll
        for (int mi = 0; mi < 4; ++mi) {
            const long row = row0 + mi * 16 + fr;
            const float rstd = rsqrtf(ss[row] * (1.f / 1024.f) + EPS);
            float s2 = 0.f;
#pragma unroll
            for (int ni = 0; ni < 4; ++ni) { const f32x4 v = acc[mi][ni] * rstd; s2 += v[0] * v[0] + v[1] * v[1] + v[2] * v[2] + v[3] * v[3];
                st_bf16x4(kva + row * 768 + col0 + ni * 16 + fq * 4, v); }
            s2 = quad_sum(s2);
            if (fq == 0) { if (cb < 4) atomicAdd(ssc + row, s2); else if (cb >= 5) atomicAdd(ssq + row, s2); }
        }
    }
};

struct EpiKvb {
    const float* ssc; bf16_t* kbuf; bf16_t* vt; unsigned char* smem;
    DEV void operator()(f32x4 (&acc)[4][4], int row0, int col0, int fr, int fq) const {
        const int cb = col0 >> 6, h = cb >> 2, sub = cb & 3;
        float rstd[4];
#pragma unroll
        for (int mi = 0; mi < 4; ++mi) rstd[mi] = rsqrtf(ssc[row0 + mi * 16 + fr] * (1.f / 256.f) + EPS);
        if (sub < 2) {
#pragma unroll
            for (int mi = 0; mi < 4; ++mi)
#pragma unroll
                for (int ni = 0; ni < 4; ++ni) st_bf16x4(kbuf + (long)(row0 + mi * 16 + fr) * 1536 + h * 192 + sub * 64 + ni * 16 + fq * 4, acc[mi][ni] * rstd[mi]);
        } else {
            const int b = row0 >> 13, t0 = row0 & (T - 1);
            store_vt_tile(acc, rstd, vt + ((long)((b * 8 + h) * 128 + (sub - 2) * 64)) * T + t0, T, smem, fr, fq);
        }
    }
};

struct EpiQb {
    const float* ssq; bf16_t* qbuf;
    DEV void operator()(f32x4 (&acc)[4][4], int row0, int col0, int fr, int fq) const {
#pragma unroll
        for (int mi = 0; mi < 4; ++mi) {
            const long row = row0 + mi * 16 + fr;
            const float rstd = rsqrtf(ssq[row] * (1.f / 384.f) + EPS);
#pragma unroll
            for (int ni = 0; ni < 4; ++ni) st_bf16x4(qbuf + row * 1536 + col0 + ni * 16 + fq * 4, acc[mi][ni] * rstd);
        }
    }
};


template <int MODE, bool MASK>
DEV void nsa_compute(const LAS unsigned char* Ks, const LAS unsigned char* Vs, int tt, const bf16x8 (&qf)[2], int t, const f32x4 (&bias)[4], float dl, bool selbit,
                     float& l, float invl, f32x4 (&O)[4], f32x4& lacc, float* IA, float& carry, int tokl, int fr, int fq) {
    const int fsw = (fr >> 1) & 7;
    f32x4 s[4];
#pragma unroll
    for (int k16 = 0; k16 < 4; ++k16) {
        s[k16] = bias[k16];
#pragma unroll
        for (int ks = 0; ks < 2; ++ks) { const bf16x8 kf = *(const LAS bf16x8*)(Ks + (k16 * 16 + fr) * 128 + (((ks * 4 + fq) ^ fsw) * 16)); s[k16] = mfma16(kf, qf[ks], s[k16]); }
    }
    if (MASK) {
#pragma unroll
        for (int k16 = 0; k16 < 4; ++k16)
#pragma unroll
            for (int r = 0; r < 4; ++r) {
                const int e = tt * 64 + k16 * 16 + fq * 4 + r;
                bool valid;
                if (MODE <= 1) valid = (16 * e + 31 <= t);
                else if (MODE == 2) valid = (e <= t);
                else valid = (e <= t) && (t - e < 512);
                s[k16][r] = valid ? s[k16][r] : -INFINITY;
            }
    }
    float sh = dl;
    if (MODE == 2) sh = selbit ? dl : -INFINITY;
    if (MODE == 1) sh = dl + invl;
    if (MODE == 0) {
        float ps = 0.f;
#pragma unroll
        for (int k16 = 0; k16 < 4; ++k16)
#pragma unroll
            for (int r = 0; r < 4; ++r) ps += fexp2(s[k16][r] + sh);
        l += ps;
        return;
    }
    {
        float ps = 0.f;
#pragma unroll
        for (int k16 = 0; k16 < 4; ++k16)
#pragma unroll
            for (int r = 0; r < 4; ++r) s[k16][r] = fexp2(s[k16][r] + sh);
        (void)ps;
    }
    if (MODE == 1) {
        const int lane = fq * 16 + fr;
#pragma unroll
        for (int k16 = 0; k16 < 4; ++k16) {
            f32x4 v = s[k16];
#pragma unroll
            for (int r = 0; r < 4; ++r) { DPP_ADD(v[r], 0xB1); DPP_ADD(v[r], 0x4E); }
            const float y = __shfl(v[3], (lane + 48) & 63);
            const float prev = fq > 0 ? y : carry;
            carry = y;
            if ((fr & 3) == 0) IA[tokl * 132 + tt * 16 + k16 * 4 + fq] = ((v[0] + v[1]) + (v[2] + v[3])) + prev;
        }
    }
#pragma unroll
    for (int ks2 = 0; ks2 < 2; ++ks2) {
        u32x4 pu;
        pu.x = pk_bf16(s[2 * ks2][0], s[2 * ks2][1]); pu.y = pk_bf16(s[2 * ks2][2], s[2 * ks2][3]);
        pu.z = pk_bf16(s[2 * ks2 + 1][0], s[2 * ks2 + 1][1]); pu.w = pk_bf16(s[2 * ks2 + 1][2], s[2 * ks2 + 1][3]);
        const bf16x8 pb = __builtin_bit_cast(bf16x8, pu);
        if (MODE >= 2) { u32x4 ou; ou.x = 0x3F803F80u; ou.y = 0x3F803F80u; ou.z = 0x3F803F80u; ou.w = 0x3F803F80u; lacc = mfma16(__builtin_bit_cast(bf16x8, ou), pb, lacc); }
#pragma unroll
        for (int dt = 0; dt < 4; ++dt) {
            const LAS unsigned char* vr = Vs + (dt * 16 + fr) * 128 + (fq & 1) * 8;
            const u32x2 v0 = *(const LAS u32x2*)(vr + (((ks2 * 4 + (fq >> 1)) ^ fsw) * 16));
            const u32x2 v1 = *(const LAS u32x2*)(vr + (((ks2 * 4 + (fq >> 1) + 2) ^ fsw) * 16));
            u32x4 vv; vv.x = v0.x; vv.y = v0.y; vv.z = v1.x; vv.w = v1.y;
            O[dt] = mfma16(__builtin_bit_cast(bf16x8, vv), pb, O[dt]);
        }
    }
}

DEV int take_bit_hi(u64& lo, u64& hi) {
    const bool usehi = hi != 0ull;
    const u64 v = usehi ? hi : lo;
    if (v == 0ull) return -1;
    const int b = 63 - __builtin_clzll(v);
    const u64 nv = v & ~(1ull << b);
    hi = usehi ? nv : hi; lo = usehi ? lo : nv;
    return b + (usehi ? 64 : 0);
}
template <int MODE> DEV int take_tile(u64& lo, u64& hi) { if (MODE >= 2) return take_bit_hi(lo, hi); else return take_bit(lo, hi); }

template <int MODE>
DEV void nsa_branch(u64 mlo, u64 mhi, u64 wlo, u64 whi, const bf16_t* kbase, long ktstride, long krs, const bf16_t* vbase, long vrs,
                    LAS unsigned char* ring, const bf16x8 (&qf)[2], int t, int s0, const f32x4 (&bias)[4], float slope2, float cadj, u64 tm0, u64 tm1,
                    float& l, float invl, f32x4 (&O)[4], f32x4& lacc, float* IA, int tokl, int fr, int fq, int abl = 0) {
    const int tid = threadIdx.x, lane = tid & 63, w = tid >> 6;
    const int t0 = take_tile<MODE>(mlo, mhi);
    if (t0 < 0) return;
    unsigned koff[2], voff[2];
#pragma unroll
    for (int j = 0; j < 2; ++j) { const int row = 8 * (w * 2 + j) + (lane >> 3), c = (lane & 7) ^ (((lane >> 4) + 4 * j) & 7); koff[j] = (unsigned)(((long)row * krs + c * 8) * 2); voff[j] = (unsigned)(((long)row * vrs + c * 8) * 2); }
    const unsigned ring_u = (unsigned)(unsigned long long)ring + (unsigned)(w * 2) * 1024u;
#define NSA_ISSUE(tt_, slot_) do { const bf16_t* kb_ = kbase + (long)(tt_) * ktstride; const bf16_t* vb_ = vbase + (long)(tt_) * 64; \
        _Pragma("unroll") for (int j_ = 0; j_ < 2; ++j_) { \
            const unsigned la_ = (unsigned)__builtin_amdgcn_readfirstlane((int)(ring_u + (unsigned)(slot_) * 16384u + (unsigned)j_ * 1024u)); \
            glds16_s(kb_, koff[j_], la_); if (MODE != 0) glds16_s(vb_, voff[j_], la_ + 8192u); } } while (0)
    const int t1 = take_tile<MODE>(mlo, mhi);
    NSA_ISSUE(t0, 0);
    if (t1 >= 0) NSA_ISSUE(t1, 1);
    int cur = t0, nxt = t1, slot = 0;
    float carry = 0.f;
    while (true) {
        const int nn = (nxt >= 0) ? take_tile<MODE>(mlo, mhi) : -1;
        if (nxt >= 0) { if (MODE == 0) asm volatile("s_waitcnt vmcnt(2)" ::: "memory"); else asm volatile("s_waitcnt vmcnt(4)" ::: "memory"); } else asm volatile("s_waitcnt vmcnt(0)" ::: "memory");
        RAW_BARRIER();
        if (nn >= 0) NSA_ISSUE(nn, (slot == 0 ? 2 : slot - 1));
        const bool wact = (((cur < 64 ? wlo : whi) >> (cur & 63)) & 1ull) != 0ull;
        if (wact && !(abl & 16)) {
            const bool selbit = (((cur < 64 ? tm0 : tm1) >> (cur & 63)) & 1ull) != 0ull;
            bool needmask; float dl;
            if (MODE <= 1) { needmask = 16 * (64 * cur + 63) + 31 > s0; dl = slope2 * (float)(1024 * cur - s0) + cadj; }
            else if (MODE == 2) { needmask = 64 * cur + 63 > s0; dl = slope2 * (float)(64 * cur - s0) + cadj; }
            else { needmask = (64 * cur + 63 > s0) || (64 * cur < s0 + 15 - 511); dl = slope2 * (float)(64 * cur - s0) + cadj; }
            if (needmask) nsa_compute<MODE, true>(ring + slot * 16384, ring + slot * 16384 + 8192, cur, qf, t, bias, dl, selbit, l, invl, O, lacc, IA, carry, tokl, fr, fq);
            else nsa_compute<MODE, false>(ring + slot * 16384, ring + slot * 16384 + 8192, cur, qf, t, bias, dl, selbit, l, invl, O, lacc, IA, carry, tokl, fr, fq);
        }
        if (nxt < 0) break;
        cur = nxt; nxt = nn; slot = (slot == 2 ? 0 : slot + 1);
    }
    RAW_BARRIER();
#undef NSA_ISSUE
}

DEV void nsa_item(const Params& p, unsigned char* smem, int bg, int s0, float Cc, float Cs, float cadj_w) {
    LAS unsigned char* ring = (LAS unsigned char*)smem;
    float* IA = (float*)(smem + 49152);
    u64* SELM = (u64*)(smem + 49152 + 16 * 132 * 4);
    const bf16_t* proj = (const bf16_t*)(p.ws + OFF_PROJ);
    const bf16_t* kcmp = (const bf16_t*)(p.ws + OFF_KCMP); const bf16_t* vcmpt = (const bf16_t*)(p.ws + OFF_VCMPT);
    const bf16_t* vslt = (const bf16_t*)(p.ws + OFF_VSLT); const bf16_t* vwt = (const bf16_t*)(p.ws + OFF_VWT);
    const float* gates = (const float*)(p.ws + OFF_GATES);
    bf16_t* obuf = (bf16_t*)(p.ws + OFF_OBUF);
    const int b = bg >> 2, g = bg & 3;
    const int tid = threadIdx.x, lane = tid & 63, w = tid >> 6, fr = lane & 15, fq = lane >> 4;
    const int tokl = w * 4 + (fr >> 2), t = s0 + tokl, head = g * 4 + (fr & 3);
    const float slope2 = exp2f(-0.5f * (float)(head + 1)) * LOG2E;
    const long row = (long)b * T + t;
    bf16x8 qf[2];
#pragma unroll
    for (int ks = 0; ks < 2; ++ks) qf[ks] = *(const bf16x8*)(proj + row * 2048 + head * 64 + ks * 32 + fq * 8);
    f32x4 bias[4];
#pragma unroll
    for (int k16 = 0; k16 < 4; ++k16)
#pragma unroll
        for (int r = 0; r < 4; ++r) bias[k16][r] = slope2 * ((float)(16 * (k16 * 16 + fq * 4 + r)) + 15.5f - (float)tokl) - Cc;
    float g0 = gates[row * 48 + head * 3 + 0], g1 = gates[row * 48 + head * 3 + 1], g2 = gates[row * 48 + head * 3 + 2];
    asm volatile("" : "+v"(qf[0]), "+v"(qf[1]), "+v"(g0), "+v"(g1), "+v"(g2));
    for (int i = tid; i < 16 * 132; i += 256) IA[i] = 0.f;
    __syncthreads();
    const u64 FULL = ~0ull;
    const int nc = ((s0 >> 4) + 63) >> 6;
    const u64 clo = nc ? ((1ull << nc) - 1ull) : 0ull;
    float l = 0.f;
    f32x4 O[4], lacc = (f32x4){0.f, 0.f, 0.f, 0.f};
#pragma unroll
    for (int dt = 0; dt < 4; ++dt) O[dt] = (f32x4){0.f, 0.f, 0.f, 0.f};
    const bf16_t* kcb = kcmp + (long)bg * 512 * 64; const bf16_t* vcb = vcmpt + (long)bg * 64 * 512;
    if (!(p.abl & 1)) {
    nsa_branch<0>(clo, 0ull, FULL, FULL, kcb, 64 * 64, 64, vcb, 512, ring, qf, t, s0, bias, slope2, 0.f, 0ull, 0ull, l, 0.f, O, lacc, IA, tokl, fr, fq);
    l = quad_sum(l);
    float invl_c = l > 0.f ? -__log2f(l) : -INFINITY;
    nsa_branch<1>(clo, 0ull, FULL, FULL, kcb, 64 * 64, 64, vcb, 512, ring, qf, t, s0, bias, slope2, 0.f, 0ull, 0ull, l, invl_c, O, lacc, IA, tokl, fr, fq);
    }
    f32x4 outacc[4];
#pragma unroll
    for (int dt = 0; dt < 4; ++dt) outacc[dt] = O[dt] * g0;
    __syncthreads();
    if (!(p.abl & 2)) {
#pragma unroll
    for (int k = 0; k < 4; ++k) {
        const int tk = w * 4 + k, tt_ = s0 + tk, curb = tt_ >> 6;
#pragma unroll
        for (int hh = 0; hh < 2; ++hh) {
            const int blk = lane + 64 * hh;
            const float imp = IA[tk * 132 + blk];
            const bool valid = blk <= curb, forced = (blk == 0) || (blk == curb) || (blk == curb - 1);
            IA[tk * 132 + blk] = valid ? imp + (forced ? 1e4f : 0.f) : -1.f;
        }
    }
    __syncthreads();
    {
        unsigned ka[4], kb[4], th[4];
#pragma unroll
        for (int k = 0; k < 4; ++k) {
            const int tk = w * 4 + k;
            const float a = IA[tk * 132 + lane], bsc = IA[tk * 132 + lane + 64];
            ka[k] = a >= 0.f ? __float_as_uint(a) + 1u : 0u; kb[k] = bsc >= 0.f ? __float_as_uint(bsc) + 1u : 0u; th[k] = 0u;
        }
#pragma unroll 1
        for (int bit = 30; bit >= 0; --bit) {
#pragma unroll
            for (int k = 0; k < 4; ++k) {
                const unsigned cand = th[k] | (1u << bit);
                const int c = __builtin_popcountll(__ballot(ka[k] >= cand)) + __builtin_popcountll(__ballot(kb[k] >= cand));
                th[k] = c >= 16 ? cand : th[k];
            }
        }
#pragma unroll
        for (int k = 0; k < 4; ++k) {
            const int tk = w * 4 + k;
            u64 m0, m1;
            if (th[k] == 0u) { m0 = __ballot(ka[k] > 0u); m1 = __ballot(kb[k] > 0u); }
            else {
                m0 = __ballot(ka[k] > th[k]); m1 = __ballot(kb[k] > th[k]);
                u64 e0 = __ballot(ka[k] == th[k]), e1 = __ballot(kb[k] == th[k]);
                int need = 16 - (__builtin_popcountll(m0) + __builtin_popcountll(m1));
                while (need > 0 && (e0 | e1)) {
                    if (e0) { const u64 bt = e0 & (0ull - e0); m0 |= bt; e0 ^= bt; } else { const u64 bt = e1 & (0ull - e1); m1 |= bt; e1 ^= bt; }
                    --need;
                }
            }
            if (lane == 0) { SELM[tk * 2 + 0] = m0; SELM[tk * 2 + 1] = m1; }
        }
    }
    __syncthreads();
    }
    u64 ulo = 0, uhi = 0, wlo = 0, whi = 0;
    for (int k = 0; k < 16; ++k) { const u64 a = SELM[k * 2], bb = SELM[k * 2 + 1]; ulo |= a; uhi |= bb; if ((k >> 2) == w) { wlo |= a; whi |= bb; } }
    ulo = uni64(ulo); uhi = uni64(uhi); wlo = uni64(wlo); whi = uni64(whi);
    const u64 tm0 = SELM[tokl * 2], tm1 = SELM[tokl * 2 + 1];
    const bf16_t* pb_ = proj + (long)b * T * 2048 + g * 64;
#pragma unroll
    for (int k16 = 0; k16 < 4; ++k16)
#pragma unroll
        for (int r = 0; r < 4; ++r) bias[k16][r] = slope2 * (float)(k16 * 16 + fq * 4 + r - tokl) - Cs;
    {
        lacc = (f32x4){0.f, 0.f, 0.f, 0.f};
#pragma unroll
        for (int dt = 0; dt < 4; ++dt) O[dt] = (f32x4){0.f, 0.f, 0.f, 0.f};
        if (!(p.abl & 4)) nsa_branch<2>(ulo, uhi, wlo, whi, pb_ + 1536, 64 * 2048, 2048, vslt + (long)bg * 64 * T, T, ring, qf, t, s0, bias, slope2, 0.f, tm0, tm1, l, 0.f, O, lacc, IA, tokl, fr, fq, p.abl);
        const float sc = (lacc[0] > 0.f ? 1.f / lacc[0] : 0.f) * g1;
#pragma unroll
        for (int dt = 0; dt < 4; ++dt) outacc[dt] += O[dt] * sc;
    }
    {
        const int wfirst = (s0 > 511 ? s0 - 511 : 0) >> 6, wlast = (s0 + 15) >> 6;
        u64 qlo = 0, qhi = 0;
        for (int i = wfirst; i <= wlast; ++i) { if (i < 64) qlo |= 1ull << i; else qhi |= 1ull << (i - 64); }
        lacc = (f32x4){0.f, 0.f, 0.f, 0.f};
#pragma unroll
        for (int dt = 0; dt < 4; ++dt) O[dt] = (f32x4){0.f, 0.f, 0.f, 0.f};
        if (!(p.abl & 8)) nsa_branch<3>(qlo, qhi, FULL, FULL, pb_ + 1792, 64 * 2048, 2048, vwt + (long)bg * 64 * T, T, ring, qf, t, s0, bias, slope2, cadj_w, 0ull, 0ull, l, 0.f, O, lacc, IA, tokl, fr, fq, p.abl);
        const float sc = (lacc[0] > 0.f ? 1.f / lacc[0] : 0.f) * g2;
#pragma unroll
        for (int dt = 0; dt < 4; ++dt) outacc[dt] += O[dt] * sc;
    }
#pragma unroll
    for (int dt = 0; dt < 4; ++dt) st_bf16x4(obuf + row * OBLD + head * 64 + dt * 16 + fq * 4, outacc[dt]);
    __syncthreads();
}

DEV void phase_nsa(const Params& p, unsigned char* smem) {
    const int nitems = 4096, G = gridDim.x;
    float Cc, Cs, cadj_w;
    {
        const int lane = threadIdx.x & 63;
        float gq = fabsf(p.in[IN_A_Q_NORM][lane]), gc = fabsf(p.in[IN_A_KCMP_NORM][lane]), gs = fabsf(p.in[IN_A_KSLC_NORM][lane]), gw = fabsf(p.in[IN_A_KWIN_NORM][lane]);
        for (int o = 1; o < 64; o <<= 1) { gq = fmaxf(gq, __shfl_xor(gq, o)); gc = fmaxf(gc, __shfl_xor(gc, o)); gs = fmaxf(gs, __shfl_xor(gs, o)); gw = fmaxf(gw, __shfl_xor(gw, o)); }
        const float k_ = 64.f * QSCALE_NSA * 1.02f * gq;
        Cc = fminf(k_ * gc + 0.5f, 40.f); Cs = fminf(k_ * gs + 0.5f, 40.f); cadj_w = Cs - fminf(k_ * gw + 0.5f, 40.f);
        Cc = __uint_as_float(__builtin_amdgcn_readfirstlane(__float_as_uint(Cc))); Cs = __uint_as_float(__builtin_amdgcn_readfirstlane(__float_as_uint(Cs)));
        cadj_w = __uint_as_float(__builtin_amdgcn_readfirstlane(__float_as_uint(cadj_w)));
    }
    for (int rr = 0; rr * G < nitems; ++rr) {
        const int idx = (rr & 1) ? (rr + 1) * G - 1 - (int)blockIdx.x : rr * G + (int)blockIdx.x;
        if (idx >= nitems) continue;
        nsa_item(p, smem, idx & 7, (511 - (idx >> 3)) * 16, Cc, Cs, cadj_w);
    }
}

DEV void phase_finish(const Params& p) {
    bf16_t* Kb = (bf16_t*)(p.ws + OFF_K); bf16_t* Qb = (bf16_t*)(p.ws + OFF_Q); const bf16_t* kva = (const bf16_t*)(p.ws + OFF_KVA);
    const float* kn = p.in[IN_KV_K_NORM]; const float* qn = p.in[IN_B_Q_NORM];
    const int tid = threadIdx.x, lane = tid & 63;
    const float inv = (float)pow(10000.0, -(double)(lane & 31) / 32.0);
    const float kn0 = kn[2 * lane], kn1 = kn[2 * lane + 1], kn2 = kn[128 + lane];
    const float qn0 = qn[2 * lane], qn1 = qn[2 * lane + 1], qn2 = qn[128 + lane];
    for (int row = blockIdx.x * 4 + (tid >> 6); row < M; row += gridDim.x * 4) {
        const int t = row & (T - 1);
        const float ang = (float)t * inv;
        const double rev = (double)ang * 0.15915494309189535;
        const float frac = (float)(rev - rint(rev));
        const float cs = __builtin_amdgcn_cosf(frac), sn = __builtin_amdgcn_sinf(frac);
        const float pe = bf2f(kva[(long)row * 768 + 256 + lane]);
        const float pess = wave_sum(pe * pe);
#pragma unroll
        for (int h = 0; h < 8; ++h) {
            {
                bf16_t* kp = Kb + (long)row * 1536 + h * 192;
                const unsigned raw = *(const unsigned*)(kp + 2 * lane);
                float a = __uint_as_float(raw << 16), bq = __uint_as_float(raw & 0xffff0000u);
                const float ss = wave_sum(a * a + bq * bq) + pess;
                const float rs = rsqrtf(ss * (1.f / 192.f) + EPS);
                a *= rs * kn0; bq *= rs * kn1;
                const float x = pe * rs * kn2, xo = __shfl_xor(x, 32);
                const float o = lane < 32 ? x * cs - xo * sn : xo * sn + x * cs;
                *(unsigned*)(kp + 2 * lane) = pk_bf16(a, bq);
                kp[128 + lane] = f2bf(o);
            }
            {
                bf16_t* qp = Qb + (long)row * 1536 + h * 192;
                const unsigned raw = *(const unsigned*)(qp + 2 * lane);
                float a = __uint_as_float(raw << 16), bq = __uint_as_float(raw & 0xffff0000u);
                float x = bf2f(qp[128 + lane]);
                const float ss = wave_sum(a * a + bq * bq + x * x);
                const float rs = rsqrtf(ss * (1.f / 192.f) + EPS);
                a *= rs * qn0 * QSCALE_MLA; bq *= rs * qn1 * QSCALE_MLA;
                x *= rs * qn2 * QSCALE_MLA;
                const float xo = __shfl_xor(x, 32);
                const float o = lane < 32 ? x * cs - xo * sn : xo * sn + x * cs;
                *(unsigned*)(qp + 2 * lane) = pk_bf16(a, bq);
                qp[128 + lane] = f2bf(o);
            }
        }
    }
}

constexpr int MLA_QT = 2;
DEV void mla_item(const Params& p, unsigned char* smem, int bh, int qb, float negC) {
    const bf16_t* Kb = (const bf16_t*)(p.ws + OFF_K); const bf16_t* Qb = (const bf16_t*)(p.ws + OFF_Q); const bf16_t* VT = (const bf16_t*)(p.ws + OFF_VT);
    bf16_t* obuf = (bf16_t*)(p.ws + OFF_OBUF);
    const int b = bh >> 3, h = bh & 7, q0 = qb * (64 * MLA_QT);
    const int tid = threadIdx.x, lane = tid & 63, w = tid >> 6, fr = lane & 15, fq = lane >> 4;
    const int wq0 = q0 + w * (16 * MLA_QT);
    bf16x8 qf[MLA_QT][6];
#pragma unroll
    for (int qt = 0; qt < MLA_QT; ++qt)
#pragma unroll
        for (int ks = 0; ks < 6; ++ks) qf[qt][ks] = *(const bf16x8*)(Qb + ((long)b * T + wq0 + qt * 16 + fr) * 1536 + h * 192 + ks * 32 + fq * 8);
#pragma unroll
    for (int qt = 0; qt < MLA_QT; ++qt) asm volatile("" : "+v"(qf[qt][0]), "+v"(qf[qt][1]), "+v"(qf[qt][2]), "+v"(qf[qt][3]), "+v"(qf[qt][4]), "+v"(qf[qt][5]));
    f32x4 O[MLA_QT][8];
    f32x4 lacc[MLA_QT];
    u32x4 ones_u; ones_u.x = 0x3F803F80u; ones_u.y = 0x3F803F80u; ones_u.z = 0x3F803F80u; ones_u.w = 0x3F803F80u;
    const bf16x8 ones = __builtin_bit_cast(bf16x8, ones_u);
#pragma unroll
    for (int qt = 0; qt < MLA_QT; ++qt) { lacc[qt] = (f32x4){0.f, 0.f, 0.f, 0.f};
#pragma unroll
        for (int dt = 0; dt < 8; ++dt) O[qt][dt] = (f32x4){0.f, 0.f, 0.f, 0.f}; }
    const int nkt = (q0 + 64 * MLA_QT) / 64;
    const bf16_t* kg = Kb + (long)b * T * 1536 + h * 192;
    const bf16_t* vg = VT + (long)(b * 8 + h) * 128 * T;
    unsigned koff[6], voff[4];
#pragma unroll
    for (int i = 0; i < 6; ++i) { const int q = (6 * w + i) * 64 + lane, r = q / 24, cp = q % 24, c = (cp & ~7) | ((cp & 7) ^ ((r >> 1) & 7)); koff[i] = (unsigned)((r * 1536 + c * 8) * 2); }
#pragma unroll
    for (int i = 0; i < 4; ++i) { const int r = 8 * (4 * w + i) + (lane >> 3), c = (lane & 7) ^ ((r >> 1) & 7); voff[i] = (unsigned)(((long)r * T + c * 8) * 2); }
    const unsigned lds_u = (unsigned)(unsigned long long)(LAS unsigned char*)smem;
    unsigned lk[2][6], lv[4];
#pragma unroll
    for (int bb = 0; bb < 2; ++bb)
#pragma unroll
        for (int i = 0; i < 6; ++i) lk[bb][i] = (unsigned)__builtin_amdgcn_readfirstlane((int)(lds_u + (unsigned)bb * 24576u + (unsigned)(6 * w + i) * 1024u));
#pragma unroll
    for (int i = 0; i < 4; ++i) lv[i] = (unsigned)__builtin_amdgcn_readfirstlane((int)(lds_u + 49152u + (unsigned)(4 * w + i) * 1024u));
#define MLA_ISSUE_K(kt_, buf_) do { const bf16_t* kb_ = kg + (long)(kt_) * 64 * 1536; _Pragma("unroll") for (int i_ = 0; i_ < 6; ++i_) glds16_s(kb_, koff[i_], lk[buf_][i_]); } while (0)
#define MLA_ISSUE_V(kt_) do { const bf16_t* vb_ = vg + (long)(kt_) * 64; _Pragma("unroll") for (int i_ = 0; i_ < 4; ++i_) glds16_s(vb_, voff[i_], lv[i_]); } while (0)
    const int fsw = (fr >> 1) & 7;
    __syncthreads();
    MLA_ISSUE_K(0, 0);
    for (int kt = 0; kt < nkt; ++kt) {
        asm volatile("s_waitcnt vmcnt(0)" ::: "memory");
        RAW_BARRIER();
        MLA_ISSUE_V(kt);
        const bool more = kt + 1 < nkt;
        if (more) { if (kt & 1) MLA_ISSUE_K(kt + 1, 0); else MLA_ISSUE_K(kt + 1, 1); }
        const bool active = !(kt * 64 > wq0 + 16 * MLA_QT - 1);
        const unsigned char* Ks = smem + (kt & 1) * 24576;
        const unsigned char* Vs = smem + 49152;
        f32x4 s[MLA_QT][4];
        bf16x8 pb[MLA_QT][2];
        if (active) {
#pragma unroll
            for (int k16 = 0; k16 < 4; ++k16) {
                _Pragma("unroll") for (int qt = 0; qt < MLA_QT; ++qt) s[qt][k16] = (f32x4){negC, negC, negC, negC};
#pragma unroll
                for (int ks = 0; ks < 6; ++ks) {
                    const int c = ks * 4 + fq;
                    const bf16x8 kf = *(const bf16x8*)(Ks + (k16 * 16 + fr) * 384 + (((c & ~7) | ((c & 7) ^ fsw)) * 16));
#pragma unroll
                    for (int qt = 0; qt < MLA_QT; ++qt) s[qt][k16] = mfma16(kf, qf[qt][ks], s[qt][k16]);
                }
            }
            const bool needmask = kt * 64 + 63 > wq0;
#pragma unroll
            for (int qt = 0; qt < MLA_QT; ++qt) {
                if (needmask) {
                    const int qpos = wq0 + qt * 16 + fr;
#pragma unroll
                    for (int k16 = 0; k16 < 4; ++k16)
#pragma unroll
                        for (int r = 0; r < 4; ++r) { const int key = kt * 64 + k16 * 16 + fq * 4 + r; if (key > qpos) s[qt][k16][r] = -INFINITY; }
                }
#pragma unroll
                for (int k16 = 0; k16 < 4; ++k16)
#pragma unroll
                    for (int r = 0; r < 4; ++r) s[qt][k16][r] = fexp2(s[qt][k16][r]);
#pragma unroll
                for (int ks2 = 0; ks2 < 2; ++ks2) {
                    u32x4 pu;
                    pu.x = pk_bf16(s[qt][2 * ks2][0], s[qt][2 * ks2][1]); pu.y = pk_bf16(s[qt][2 * ks2][2], s[qt][2 * ks2][3]);
                    pu.z = pk_bf16(s[qt][2 * ks2 + 1][0], s[qt][2 * ks2 + 1][1]); pu.w = pk_bf16(s[qt][2 * ks2 + 1][2], s[qt][2 * ks2 + 1][3]);
                    pb[qt][ks2] = __builtin_bit_cast(bf16x8, pu);
                    lacc[qt] = mfma16(ones, pb[qt][ks2], lacc[qt]);
                }
            }
        }
        if (more) asm volatile("s_waitcnt vmcnt(6)" ::: "memory"); else asm volatile("s_waitcnt vmcnt(0)" ::: "memory");
        RAW_BARRIER();
        if (active) {
#pragma unroll
            for (int ks2 = 0; ks2 < 2; ++ks2)
#pragma unroll
                for (int dt = 0; dt < 8; ++dt) {
                    const unsigned char* vr = Vs + (dt * 16 + fr) * 128 + (fq & 1) * 8;
                    const u32x2 v0 = *(const u32x2*)(vr + (((ks2 * 4 + (fq >> 1)) ^ fsw) * 16));
                    const u32x2 v1 = *(const u32x2*)(vr + (((ks2 * 4 + (fq >> 1) + 2) ^ fsw) * 16));
                    u32x4 vv; vv.x = v0.x; vv.y = v0.y; vv.z = v1.x; vv.w = v1.y;
                    const bf16x8 vf = __builtin_bit_cast(bf16x8, vv);
#pragma unroll
                    for (int qt = 0; qt < MLA_QT; ++qt) O[qt][dt] = mfma16(vf, pb[qt][ks2], O[qt][dt]);
                }
        }
    }
#undef MLA_ISSUE_K
#undef MLA_ISSUE_V
#pragma unroll
    for (int qt = 0; qt < MLA_QT; ++qt) {
        const float lt_ = lacc[qt][0];
        const float il = lt_ > 0.f ? 1.f / lt_ : 0.f;
        const long row = (long)b * T + wq0 + qt * 16 + fr;
#pragma unroll
        for (int dt = 0; dt < 8; ++dt) st_bf16x4(obuf + row * OBLD + h * 128 + dt * 16 + fq * 4, O[qt][dt] * il);
    }
    RAW_BARRIER();
}

DEV void phase_mla(const Params& p, unsigned char* smem) {
    float negC;
    {
        const int lane = threadIdx.x & 63;
        const float* kn = p.in[IN_KV_K_NORM]; const float* qn = p.in[IN_B_Q_NORM];
        float gk = fmaxf(fmaxf(fabsf(kn[lane]), fabsf(kn[64 + lane])), fabsf(kn[128 + lane]));
        float gq = fmaxf(fmaxf(fabsf(qn[lane]), fabsf(qn[64 + lane])), fabsf(qn[128 + lane]));
        for (int o = 1; o < 64; o <<= 1) { gk = fmaxf(gk, __shfl_xor(gk, o)); gq = fmaxf(gq, __shfl_xor(gq, o)); }
        negC = -fminf(192.f * QSCALE_MLA * 1.02f * gk * gq + 0.5f, 60.f);
        negC = __uint_as_float(__builtin_amdgcn_readfirstlane(__float_as_uint(negC)));
    }
    const int nitems = 16 * (T / (64 * MLA_QT)), G = gridDim.x;
    for (int rr = 0; rr * G < nitems; ++rr) {
        const int idx = (rr & 1) ? (rr + 1) * G - 1 - (int)blockIdx.x : rr * G + (int)blockIdx.x;
        if (idx >= nitems) continue;
        mla_item(p, smem, idx & 15, (T / (64 * MLA_QT)) - 1 - (idx >> 4), negC);
    }
}


#define XB_TMO      128
#define XB_XCNT(j)  (256  + 64 * (j))
#define XB_XSUB(j)  (1280 + 64 * (j))
#define XB_XGEN(j)  (2304 + 64 * (j))
#define XB_TOP      3328
#define XB_TOPGEN   3392
#define XCD_BAR_WORDS 3456
#define XB_SPIN_CAP (1u << 20)
DEV unsigned xb_ld(unsigned* p)              { return __hip_atomic_load(p, __ATOMIC_RELAXED, __HIP_MEMORY_SCOPE_AGENT); }
DEV unsigned xb_add(unsigned* p, unsigned v) { return __hip_atomic_fetch_add(p, v, __ATOMIC_RELAXED, __HIP_MEMORY_SCOPE_AGENT); }
DEV unsigned xb_xcc_id() { return (unsigned)__builtin_amdgcn_s_getreg((3 << 11) | 20) & 0xFu; }
#define XB_SPIN(cond, bar) do { unsigned _sp = 0; while (cond) { __builtin_amdgcn_s_sleep(1); \
    if ((++_sp & 255u) == 0u) { if (xb_ld(&(bar)[XB_TMO])) break; if (_sp > XB_SPIN_CAP) { atomicAdd(&(bar)[XB_TMO], 1u); break; } } } } while (0)
struct XcdBarrier { unsigned* bar; unsigned x; volatile LAS unsigned* st; };
DEV XcdBarrier xcd_barrier_post(unsigned* bar, volatile LAS unsigned* st) {
    XcdBarrier b; b.bar = bar; b.x = xb_xcc_id(); b.st = st;
    if (threadIdx.x == 0) (void)xb_add(&bar[XB_XCNT(b.x)], 1u);
    return b;
}
DEV void xcd_barrier_complete(unsigned* bar, unsigned x, unsigned& nloc, unsigned& nx) {
    const unsigned G = gridDim.x * gridDim.y * gridDim.z;
    unsigned sum, cnt, mine, sp = 0u;
    for (;;) {
        sum = 0u; cnt = 0u; mine = 0u;
#pragma unroll
        for (unsigned j = 0; j < 16; ++j) { const unsigned c = xb_ld(&bar[XB_XCNT(j)]); sum += c; cnt += (c > 0u) ? 1u : 0u; mine = (j == x) ? c : mine; }
        if (sum == G) break;
        __builtin_amdgcn_s_sleep(1);
        if ((++sp & 255u) == 0u) { if (xb_ld(&bar[XB_TMO])) break; if (sp > XB_SPIN_CAP) { atomicAdd(&bar[XB_TMO], 1u); break; } }
    }
    nloc = mine > 0u ? mine : 1u; nx = cnt > 0u ? cnt : 1u;
}
DEV void xcd_barrier(const XcdBarrier& b) {
    asm volatile("s_waitcnt vmcnt(0)" ::: "memory");
    __syncthreads();
    if (threadIdx.x == 0) {
        unsigned* bar = b.bar;
        __builtin_amdgcn_s_waitcnt(0);
        unsigned nloc = b.st[0], nx = b.st[1];
        if (nloc == 0u) { xcd_barrier_complete(bar, b.x, nloc, nx); b.st[0] = nloc; b.st[1] = nx; }
        const unsigned old = xb_add(&bar[XB_XSUB(b.x)], 1u);
        const unsigned gen = old / nloc;
        if (old + 1u == (gen + 1u) * nloc) {
            __builtin_amdgcn_fence(__ATOMIC_RELEASE, "agent");
            asm volatile("s_waitcnt vmcnt(0)" ::: "memory");
            const unsigned og = xb_add(&bar[XB_TOP], 1u);
            const unsigned tg = og / nx;
            if (og + 1u == (tg + 1u) * nx) xb_add(&bar[XB_TOPGEN], 1u);
            else XB_SPIN(xb_ld(&bar[XB_TOPGEN]) == tg, bar);
            __builtin_amdgcn_fence(__ATOMIC_ACQUIRE, "agent");
            xb_add(&bar[XB_XGEN(b.x)], 1u);
            asm volatile("s_waitcnt vmcnt(0)" ::: "memory");
        } else {
            XB_SPIN(xb_ld(&bar[XB_XGEN(b.x)]) == gen, bar);
            __builtin_amdgcn_fence(__ATOMIC_ACQUIRE, "agent");
            asm volatile("s_waitcnt vmcnt(0)" ::: "memory");
        }
    }
    __syncthreads();
}

constexpr int N_PHASES = 15;

DEV void run_phase(const Params& p, int ph, unsigned char* smem) {
    unsigned char* ws = p.ws;
    float* SS = (float*)(ws + OFF_SS);
    const int G = gridDim.x, bid = blockIdx.x;
#ifdef PHASE_MASK
    if (!((PHASE_MASK >> ph) & 1)) return;
#endif
    switch (ph) {
    case 0: phase_prologue(p, smem); break;
    case 1: {
        EpiInProj e{SS, p.in[IN_A_Q_NORM], p.in[IN_A_KSLC_NORM], p.in[IN_A_KWIN_NORM], (bf16_t*)(ws + OFF_PROJ), (bf16_t*)(ws + OFF_VSLT), (bf16_t*)(ws + OFF_VWT), (float*)(ws + OFF_GATES), smem};
        for (int tl = bid; tl < 128 * 21; tl += G) gemm_tile(RowLin{XBLD}, (const bf16_t*)(ws + OFF_XB), 64, (const bf16_t*)(ws + OFF_WT_IN), 1024, tl / 21, tl % 21, e, smem);
    } break;
    case 2: {
        trans_range(p, NJOBS_L0, p.njobs, G > 256 ? 128 : 0, (float*)smem);
        for (int tl = bid; tl < 128; tl += G) {
            const int which = tl >> 6, r = tl & 63;
            EpiCmp1 e{(const float*)(ws + OFF_B1) + which * 256, (bf16_t*)(ws + OFF_HID) + (size_t)which * 4096 * 256};
            gemm_tile(RowCmp{which ? 1280 : 1024}, (const bf16_t*)(ws + OFF_PROJ), 2048, (const bf16_t*)(ws + (which ? OFF_WT_C1V : OFF_WT_C1K)), 2048, r >> 1, r & 1, e, smem);
        }
    } break;
    case 3: {
        for (int tl = bid; tl < 64; tl += G) {
            const int which = tl >> 5, r = tl & 31;
            EpiCmp2 e{which, p.in[IN_A_KCMP_NORM], (bf16_t*)(ws + OFF_KCMP), (bf16_t*)(ws + OFF_VCMPT)};
            gemm_tile(RowLin{256}, (const bf16_t*)(ws + OFF_HID) + (size_t)which * 4096 * 256, 64, (const bf16_t*)(ws + (which ? OFF_WT_C2V : OFF_WT_C2K)), 256, r, 0, e, smem);
        }
    } break;
    case 4: phase_nsa(p, smem); break;
    case 5: case 12: {
        const bool l0 = ph == 5;
        EpiResid e{l0 ? p.in[IN_X] : p.out, p.out, (bf16_t*)(ws + OFF_XB), SS + (l0 ? 1 : 3) * M};
        const bf16_t* wt = (const bf16_t*)(ws + (l0 ? OFF_WT_OUT0 : OFF_WT_OUT1));
        for (int tl = bid; tl < 128 * 8; tl += G) gemm_tile(RowLin{OBLD}, (const bf16_t*)(ws + OFF_OBUF), 64, wt, 1024, tl >> 3, tl & 7, e, smem);
    } break;
    case 6: case 13: {
        const bool l0 = ph == 6;
        EpiGateUp e{SS + (l0 ? 1 : 3) * M, (bf16_t*)(ws + OFF_HBUF)};
        const bf16_t* wt = (const bf16_t*)(ws + (l0 ? OFF_WT_GU0 : OFF_WT_GU1));
        for (int tl = bid; tl < 128 * 44; tl += G) gemm_tile(RowLin{XBLD}, (const bf16_t*)(ws + OFF_XB), 64, wt, 1024, tl / 44, tl % 44, e, smem);
    } break;
    case 7: case 14: {
        const bool l0 = ph == 7;
        EpiResid e{p.out, p.out, (bf16_t*)(ws + OFF_XB), l0 ? SS + 2 * M : (float*)nullptr};
        const bf16_t* wt = (const bf16_t*)(ws + (l0 ? OFF_WT_DN0 : OFF_WT_DN1));
        for (int tl = bid; tl < 128 * 8; tl += G) gemm_tile(RowLin{2816}, (const bf16_t*)(ws + OFF_HBUF), 64, wt, 2816, tl >> 3, tl & 7, e, smem);
    } break;
    case 8: {
        EpiKvqa e{SS + 2 * M, (bf16_t*)(ws + OFF_KVA), SS + 4 * M, SS + 5 * M};
        for (int tl = bid; tl < 128 * 6; tl += G) gemm_tile(RowLin{XBLD}, (const bf16_t*)(ws + OFF_XB), 64, (const bf16_t*)(ws + OFF_WT_KVQA), 1024, tl / 6, tl % 6, e, smem);
    } break;
    case 9: {
        EpiKvb ek{SS + 4 * M, (bf16_t*)(ws + OFF_K), (bf16_t*)(ws + OFF_VT), smem};
        EpiQb eq{SS + 5 * M, (bf16_t*)(ws + OFF_Q)};
        for (int tl = bid; tl < 128 * 16 + 128 * 12; tl += G) {
            if (tl < 2048) gemm_tile(RowLin{768}, (const bf16_t*)(ws + OFF_KVA), 64, (const bf16_t*)(ws + OFF_WT_KVB), 256, tl >> 4, tl & 15, ek, smem);
            else { const int u = tl - 2048; gemm_tile(RowLin{768}, (const bf16_t*)(ws + OFF_KVA) + 320, 64, (const bf16_t*)(ws + OFF_WT_QB), 384, u / 12, u % 12, eq, smem); }
        }
    } break;
    case 10: phase_finish(p); break;
    case 11: phase_mla(p, smem); break;
    default: break;
    }
}

__global__ void __launch_bounds__(256, 2) fwd_kernel(Params p) {
    __shared__ __attribute__((aligned(16))) unsigned char smem[65536];
#if COOP
    cg::grid_group grid = cg::this_grid();
    __shared__ uint4 xb_words;
    if (threadIdx.x == 0) xb_words = make_uint4(0u, 0u, 0u, 0u);
    __syncthreads();
    const XcdBarrier xb = xcd_barrier_post((unsigned*)(p.ws + OFF_BAR), (volatile LAS unsigned*)&xb_words);
    if (p.ph0 != 0) grid.sync();
    run_phase(p, 0, smem); xcd_barrier(xb);
    run_phase(p, 1, smem); xcd_barrier(xb);
    run_phase(p, 2, smem); xcd_barrier(xb);
    run_phase(p, 3, smem); xcd_barrier(xb);
    run_phase(p, 4, smem); xcd_barrier(xb);
    run_phase(p, 5, smem); xcd_barrier(xb);
    run_phase(p, 6, smem); xcd_barrier(xb);
    run_phase(p, 7, smem); xcd_barrier(xb);
    run_phase(p, 8, smem); xcd_barrier(xb);
    run_phase(p, 9, smem); xcd_barrier(xb);
    run_phase(p, 10, smem); xcd_barrier(xb);
    run_phase(p, 11, smem); xcd_barrier(xb);
    run_phase(p, 12, smem); xcd_barrier(xb);
    run_phase(p, 13, smem); xcd_barrier(xb);
    run_phase(p, 14, smem);
#else
    run_phase(p, p.ph0, smem);
#endif
}

static void add_job(Params& p, const float* src, const float* gain, size_t dst_off, int dst_row0, int K, int ldsrc, int nvalid, int nchunks, int mode) {
    TJob& j = p.jobs[p.njobs++];
    j.src = src; j.gain = gain; j.dst = (bf16_t*)(p.ws + dst_off) + (size_t)dst_row0 * (K + 64); j.ldd = K + 64; j.K = K; j.ldsrc = ldsrc; j.nvalid = nvalid; j.nchunks = nchunks; j.mode = mode; j.tile0 = p.ntrans;
    p.ntrans += (K / 64) * ((nchunks + 3) / 4);
}

extern "C" void kernel_launch(void* const* d_in, const int* in_sizes, int n_in, void* d_out, int out_size, void* d_ws, size_t ws_size, hipStream_t stream) {
    Params p;
    memset(&p, 0, sizeof(p));
    for (int i = 0; i < N_IN; ++i) p.in[i] = (const float*)d_in[i];
    p.out = (float*)d_out; p.ws = (unsigned char*)d_ws;
    if (ws_size < WS_NEED) { fprintf(stderr, "workspace too small: %zu < %zu\n", ws_size, (size_t)WS_NEED); return; }
    const float* ffn_norm = p.in[IN_FFN_NORM]; const float* wgu = p.in[IN_FFN_W_GU]; const float* wdn = p.in[IN_FFN_W_DN];
    add_job(p, p.in[IN_A_W_IN], p.in[IN_A_ATTN_NORM], OFF_WT_IN, 0, 1024, 2608, 2608, 84, 0);
    add_job(p, p.in[IN_K_W1], nullptr, OFF_WT_C1K, 0, 2048, 256, 256, 8, 0);
    add_job(p, p.in[IN_V_W1], nullptr, OFF_WT_C1V, 0, 2048, 256, 256, 8, 0);
    add_job(p, p.in[IN_K_W2], nullptr, OFF_WT_C2K, 0, 256, 64, 64, 4, 0);
    add_job(p, p.in[IN_V_W2], nullptr, OFF_WT_C2V, 0, 256, 64, 64, 4, 0);
    add_job(p, p.in[IN_A_W_OUT], nullptr, OFF_WT_OUT0, 0, 1024, 1024, 1024, 32, 0);
    add_job(p, wgu, ffn_norm, OFF_WT_GU0, 0, 1024, 5632, 5632, 176, 1);
    add_job(p, wdn, nullptr, OFF_WT_DN0, 0, 2816, 1024, 1024, 32, 0);
    add_job(p, p.in[IN_KV_W_A], p.in[IN_KV_NORM], OFF_WT_KVQA, 0, 1024, 320, 320, 10, 0);
    add_job(p, p.in[IN_B_W_Q_A], p.in[IN_B_ATTN_NORM], OFF_WT_KVQA, 320, 1024, 384, 384, 14, 0);
    add_job(p, p.in[IN_KV_W_B], p.in[IN_KV_C_NORM], OFF_WT_KVB, 0, 256, 2048, 2048, 64, 0);
    add_job(p, p.in[IN_B_W_Q_B], p.in[IN_B_Q_A_NORM], OFF_WT_QB, 0, 384, 1536, 1536, 48, 0);
    add_job(p, p.in[IN_B_W_OUT], nullptr, OFF_WT_OUT1, 0, 1024, 1024, 1024, 32, 0);
    add_job(p, wgu + (size_t)1024 * 5632, ffn_norm + 1024, OFF_WT_GU1, 0, 1024, 5632, 5632, 176, 1);
    add_job(p, wdn + (size_t)2816 * 1024, nullptr, OFF_WT_DN1, 0, 2816, 1024, 1024, 32, 0);
    static int grid = 0;
    if (!grid) {
        int dev = 0, cus = 0, per_cu = 0;
        hipGetDevice(&dev);
        hipDeviceGetAttribute(&cus, hipDeviceAttributeMultiprocessorCount, dev);
        hipOccupancyMaxActiveBlocksPerMultiprocessor(&per_cu, fwd_kernel, 256, 0);
        if (per_cu > 2) per_cu = 2;
        if (per_cu < 1) per_cu = 1;
        if (cus <= 0) cus = 256;
        grid = cus * per_cu;
    }
#if COOP
    p.ph0 = 0; p.ph1 = N_PHASES;
    hipMemsetAsync(p.ws + OFF_BAR, 0, XCD_BAR_WORDS * 4, stream);
    void* args[] = {&p};
    hipError_t e = hipLaunchCooperativeKernel((void*)fwd_kernel, dim3(grid), dim3(256), args, 0, stream);
    if (e != hipSuccess) fprintf(stderr, "cooperative launch failed: %s\n", hipGetErrorString(e));
#else
    for (int ph = 0; ph < N_PHASES; ++ph) {
        p.ph0 = ph; p.ph1 = ph + 1;
#ifdef DUP_PHASE
        if (ph == DUP_PHASE) { p.abl = DUP_ABL; for (int rep = 0; rep < DUP_REPS; ++rep) fwd_kernel<<<grid, 256, 0, stream>>>(p); p.abl = 0; }
#endif
        fwd_kernel<<<grid, 256, 0, stream>>>(p);
    }
#endif
}
```

```cpp
#include <hip/hip_runtime.h>
#include <hip/hip_cooperative_groups.h>
#include <stdint.h>
#include <string.h>
#include <stdio.h>
namespace cg = cooperative_groups;

#ifndef COOP
#define COOP 1
#endif

typedef unsigned short bf16_t;
typedef short bf16x8 __attribute__((ext_vector_type(8)));
typedef float f32x4 __attribute__((ext_vector_type(4)));
typedef unsigned u32x4 __attribute__((ext_vector_type(4)));
typedef unsigned u32x2 __attribute__((ext_vector_type(2)));
typedef unsigned long long u64;
#define DEV __device__ __forceinline__

constexpr int T = 8192, M = 16384;
constexpr float EPS = 1e-6f;
constexpr float LOG2E = 1.4426950408889634f;
constexpr float QSCALE_NSA = 0.125f * LOG2E;
constexpr float QSCALE_MLA = 0.07216878364870322f * LOG2E;

enum { IN_X = 0, IN_A_ATTN_NORM, IN_A_W_IN, IN_A_Q_NORM, IN_A_KCMP_NORM, IN_A_KSLC_NORM, IN_A_KWIN_NORM, IN_POS_K, IN_POS_V,
       IN_K_W1, IN_K_B1, IN_K_W2, IN_V_W1, IN_V_B1, IN_V_W2, IN_A_W_OUT, IN_KV_NORM, IN_KV_W_A, IN_KV_C_NORM, IN_KV_W_B, IN_KV_K_NORM,
       IN_B_ATTN_NORM, IN_B_W_Q_A, IN_B_Q_A_NORM, IN_B_W_Q_B, IN_B_Q_NORM, IN_B_W_OUT, IN_FFN_NORM, IN_FFN_W_GU, IN_FFN_W_DN, N_IN };

constexpr size_t OFF_WT_IN = 0;
constexpr size_t OFF_WT_C1K = OFF_WT_IN + (size_t)2688 * 1088 * 2;
constexpr size_t OFF_WT_C1V = OFF_WT_C1K + (size_t)256 * 2112 * 2;
constexpr size_t OFF_WT_C2K = OFF_WT_C1V + (size_t)256 * 2112 * 2;
constexpr size_t OFF_WT_C2V = OFF_WT_C2K + (size_t)128 * 320 * 2;
constexpr size_t OFF_WT_OUT0 = OFF_WT_C2V + (size_t)128 * 320 * 2;
constexpr size_t OFF_WT_GU0 = OFF_WT_OUT0 + (size_t)1024 * 1088 * 2;
constexpr size_t OFF_WT_DN0 = OFF_WT_GU0 + (size_t)5632 * 1088 * 2;
constexpr size_t OFF_WT_KVQA = OFF_WT_DN0 + (size_t)1024 * 2880 * 2;
constexpr size_t OFF_WT_KVB = OFF_WT_KVQA + (size_t)768 * 1088 * 2;
constexpr size_t OFF_WT_QB = OFF_WT_KVB + (size_t)2048 * 320 * 2;
constexpr size_t OFF_WT_OUT1 = OFF_WT_QB + (size_t)1536 * 448 * 2;
constexpr size_t OFF_WT_GU1 = OFF_WT_OUT1 + (size_t)1024 * 1088 * 2;
constexpr size_t OFF_WT_DN1 = OFF_WT_GU1 + (size_t)5632 * 1088 * 2;
constexpr size_t OFF_B1 = OFF_WT_DN1 + (size_t)1024 * 2880 * 2;
constexpr size_t OFF_SS = OFF_B1 + 2048;
constexpr size_t OFF_GATES = OFF_SS + (size_t)6 * M * 4;
constexpr size_t OFF_HID = OFF_GATES + (size_t)M * 48 * 4;
constexpr size_t OFF_KCMP = OFF_HID + (size_t)2 * 4096 * 256 * 2;
constexpr size_t OFF_VCMPT = OFF_KCMP + (size_t)8 * 512 * 64 * 2;
constexpr size_t OFF_XB = OFF_VCMPT + (size_t)8 * 64 * 512 * 2;
constexpr int XBLD = 1088, OBLD = 1088;
constexpr size_t OFF_OBUF = OFF_XB + (size_t)M * XBLD * 2;
constexpr size_t OFF_A = OFF_OBUF + (size_t)M * OBLD * 2;
constexpr size_t OFF_PROJ = OFF_A;
constexpr size_t OFF_VSLT = OFF_PROJ + (size_t)M * 2048 * 2;
constexpr size_t OFF_VWT = OFF_VSLT + (size_t)8 * 64 * T * 2;
constexpr size_t OFF_HBUF = OFF_A;
constexpr size_t OFF_K = OFF_A;
constexpr size_t OFF_Q = OFF_K + (size_t)M * 1536 * 2;
constexpr size_t OFF_VT = OFF_XB;
constexpr size_t OFF_KVA = OFF_OBUF;
constexpr size_t OFF_BAR = OFF_Q + (size_t)M * 1536 * 2;
constexpr size_t WS_NEED = OFF_BAR + 16384;
static_assert(WS_NEED <= (size_t)256 * 1024 * 1024, "workspace layout exceeds 256 MiB");

struct TJob { const float* src; const float* gain; bf16_t* dst; int K, ldsrc, nvalid, nchunks, mode, tile0, ldd, pad; };
struct Params {
    const float* in[N_IN];
    float* out;
    unsigned char* ws;
    TJob jobs[16];
    int njobs, ntrans, ph0, ph1, abl, pad;
};

typedef float f32x2_ __attribute__((ext_vector_type(2)));
typedef __bf16 bf16x2_ __attribute__((ext_vector_type(2)));
DEV unsigned pk_bf16(float lo, float hi) { const f32x2_ v = {lo, hi}; return __builtin_bit_cast(unsigned, __builtin_convertvector(v, bf16x2_)); }
DEV int otid() { int t = threadIdx.x; asm volatile("" : "+v"(t)); return t; }
DEV float bf2f(bf16_t h) { return __uint_as_float((unsigned)h << 16); }
DEV bf16_t f2bf(float f) { return (bf16_t)(pk_bf16(f, 0.f) & 0xffffu); }
DEV void st_bf16x4(bf16_t* p, f32x4 v) { u32x2 u; u.x = pk_bf16(v[0], v[1]); u.y = pk_bf16(v[2], v[3]); *(u32x2*)p = u; }
DEV float quad_sum(float v) {
    u32x2 r = __builtin_amdgcn_permlane16_swap(__float_as_uint(v), __float_as_uint(v), false, false);
    v = __uint_as_float(r.x) + __uint_as_float(r.y);
    r = __builtin_amdgcn_permlane32_swap(__float_as_uint(v), __float_as_uint(v), false, false);
    return __uint_as_float(r.x) + __uint_as_float(r.y);
}
DEV float quad_max(float v) {
    u32x2 r = __builtin_amdgcn_permlane16_swap(__float_as_uint(v), __float_as_uint(v), false, false);
    v = fmaxf(__uint_as_float(r.x), __uint_as_float(r.y));
    r = __builtin_amdgcn_permlane32_swap(__float_as_uint(v), __float_as_uint(v), false, false);
    return fmaxf(__uint_as_float(r.x), __uint_as_float(r.y));
}
#define DPP_ADD(v, ctrl) (v) += __uint_as_float((unsigned)__builtin_amdgcn_update_dpp(0, (int)__float_as_uint(v), (ctrl), 0xF, 0xF, true))
DEV float wave_sum(float v) {
    DPP_ADD(v, 0xB1); DPP_ADD(v, 0x4E); DPP_ADD(v, 0x141); DPP_ADD(v, 0x140);
    return quad_sum(v);
}
DEV float fexp2(float x) { return __builtin_amdgcn_exp2f(x); }
DEV float sigmoidf_(float x) { return 1.f / (1.f + __expf(-x)); }
DEV f32x4 mfma16(bf16x8 a, bf16x8 b, f32x4 c) { return __builtin_amdgcn_mfma_f32_16x16x32_bf16(a, b, c, 0, 0, 0); }
DEV int take_bit(u64& lo, u64& hi) {
    const bool uselo = lo != 0ull;
    const u64 v = uselo ? lo : hi;
    if (v == 0ull) return -1;
    const int b = __builtin_ctzll(v);
    const u64 nv = v & (v - 1ull);
    lo = uselo ? nv : lo; hi = uselo ? hi : nv;
    return b + (uselo ? 0 : 64);
}
DEV u64 uni64(u64 v) { unsigned lo = __builtin_amdgcn_readfirstlane((unsigned)v), hi = __builtin_amdgcn_readfirstlane((unsigned)(v >> 32)); return ((u64)hi << 32) | lo; }

DEV void trans_tile(const TJob& jb, int lt, float* tl) {
    const int nk = jb.K >> 6, kt = lt % nk, sc = lt / nk, tid = threadIdx.x;
    float4 v[4][2];
#pragma unroll
    for (int c = 0; c < 4; ++c) {
        const int ch = sc * 4 + c;
        const int col0 = (jb.mode == 1) ? ((ch & 1) * 2816 + (ch >> 2) * 64 + ((ch >> 1) & 1) * 32) : ch * 32;
#pragma unroll
        for (int i = 0; i < 2; ++i) {
            const int idx = tid + i * 256, k = idx >> 3, col = col0 + (idx & 7) * 4;
            v[c][i] = make_float4(0.f, 0.f, 0.f, 0.f);
            if (ch < jb.nchunks && col < jb.nvalid) v[c][i] = *(const float4*)(jb.src + (size_t)(kt * 64 + k) * jb.ldsrc + col);
        }
    }
#pragma unroll
    for (int i = 0; i < 2; ++i) {
        const int idx = tid + i * 256, k = idx >> 3, c4 = (idx & 7) * 4;
        const float gn = jb.gain ? jb.gain[kt * 64 + k] : 1.f;
#pragma unroll
        for (int c = 0; c < 4; ++c) {
            float* t_ = tl + c * (64 * 33) + k * 33 + c4;
            t_[0] = v[c][i].x * gn; t_[1] = v[c][i].y * gn; t_[2] = v[c][i].z * gn; t_[3] = v[c][i].w * gn;
        }
    }
    __syncthreads();
    {
        const int n = tid >> 3, k8 = (tid & 7) * 8;
#pragma unroll
        for (int c = 0; c < 4; ++c) {
            const int ch = sc * 4 + c;
            if (ch < jb.nchunks) {
                const float* t_ = tl + c * (64 * 33) + n;
                u32x4 o;
                o.x = pk_bf16(t_[(k8 + 0) * 33], t_[(k8 + 1) * 33]); o.y = pk_bf16(t_[(k8 + 2) * 33], t_[(k8 + 3) * 33]);
                o.z = pk_bf16(t_[(k8 + 4) * 33], t_[(k8 + 5) * 33]); o.w = pk_bf16(t_[(k8 + 6) * 33], t_[(k8 + 7) * 33]);
                *(u32x4*)(jb.dst + (size_t)(ch * 32 + n) * jb.ldd + kt * 64 + k8) = o;
            }
        }
    }
    __syncthreads();
}

DEV void trans_range(const Params& p, int j0, int j1, int b0, float* tl) {
    const int t0 = p.jobs[j0].tile0, t1 = (j1 < p.njobs) ? p.jobs[j1].tile0 : p.ntrans;
    if ((int)blockIdx.x < b0) return;
    for (int it = t0 + (int)blockIdx.x - b0; it < t1; it += gridDim.x - b0) {
        int j = j0;
        while (j + 1 < j1 && it >= p.jobs[j + 1].tile0) ++j;
        trans_tile(p.jobs[j], it - p.jobs[j].tile0, tl);
    }
}

constexpr int NJOBS_L0 = 8;

DEV void phase_prologue(const Params& p, unsigned char* smem) {
    float* tl = (float*)smem;
    const int tid = threadIdx.x;
    trans_range(p, 0, NJOBS_L0, 0, tl);
    if (blockIdx.x < 32) {
        const int which = blockIdx.x >> 4, col = (blockIdx.x & 15) * 16 + (tid & 15), kl = tid >> 4;
        const float* w1 = p.in[which ? IN_V_W1 : IN_K_W1];
        const float* pe = p.in[which ? IN_POS_V : IN_POS_K];
        const float* b1 = p.in[which ? IN_V_B1 : IN_K_B1];
        float a = 0.f;
#pragma unroll 8
        for (int k = kl; k < 2048; k += 16) a += pe[k] * w1[(size_t)k * 256 + col];
        a += __shfl_xor(a, 16); a += __shfl_xor(a, 32);
        float* red = (float*)smem;
        __syncthreads();
        if ((tid & 63) < 16) red[(tid >> 6) * 16 + (tid & 15)] = a;
        __syncthreads();
        if (tid < 16) ((float*)(p.ws + OFF_B1))[which * 256 + col] = b1[col] + ((red[tid] + red[16 + tid]) + (red[32 + tid] + red[48 + tid]));
        __syncthreads();
    }
    {
        const float* x = p.in[IN_X];
        bf16_t* xb = (bf16_t*)(p.ws + OFF_XB);
        float* ss = (float*)(p.ws + OFF_SS);
        const int lane = tid & 63;
        for (int row = (blockIdx.x * 4 + (tid >> 6)) * 2; row < M; row += gridDim.x * 8) {
            float4 v[2][4];
#pragma unroll
            for (int r = 0; r < 2; ++r)
#pragma unroll
                for (int i = 0; i < 4; ++i) v[r][i] = *(const float4*)(x + (size_t)(row + r) * 1024 + i * 256 + lane * 4);
#pragma unroll
            for (int r = 0; r < 2; ++r) {
                float s_ = 0.f;
#pragma unroll
                for (int i = 0; i < 4; ++i) {
                    s_ += v[r][i].x * v[r][i].x + v[r][i].y * v[r][i].y + v[r][i].z * v[r][i].z + v[r][i].w * v[r][i].w;
                    st_bf16x4(xb + (size_t)(row + r) * XBLD + i * 256 + lane * 4, (f32x4){v[r][i].x, v[r][i].y, v[r][i].z, v[r][i].w});
                }
                s_ = wave_sum(s_);
                if (lane == 0) ss[row + r] = s_;
            }
        }
        for (int i = blockIdx.x * 256 + tid; i < 5 * M; i += gridDim.x * 256) ss[M + i] = 0.f;
    }
}

#define LAS __attribute__((address_space(3)))
#define RAW_BARRIER() do { asm volatile("s_waitcnt lgkmcnt(0)" ::: "memory"); __builtin_amdgcn_s_barrier(); asm volatile("" ::: "memory"); } while (0)
DEV void glds16_asm(const void* gsrc, unsigned lds_dst) {
    asm volatile("s_mov_b32 m0, %1\n\ts_nop 0\n\tglobal_load_lds_dwordx4 %0, off" :: "v"(gsrc), "s"(lds_dst) : "m0", "memory");
}


struct RowLin { long lda; DEV long operator()(int r) const { return (long)r * lda; } };
struct RowCmp { int colbase; DEV long operator()(int r) const { const int bg = r >> 9; int j = r & 511; if (j > 510) j = 510;
    return ((long)((bg >> 2) * T + 16 * j)) * 2048 + colbase + (bg & 3) * 64; } };

DEV void glds16_s(const void* sbase, unsigned voff, unsigned lds_dst) {
    asm volatile("s_mov_b32 m0, %2\n\ts_nop 0\n\tglobal_load_lds_dwordx4 %0, %1" :: "v"(voff), "s"(sbase), "s"(lds_dst) : "m0", "memory");
}

template <class RowMap, class Epi>
DEV void gemm_tile(const RowMap& rm, const bf16_t* __restrict__ A, long a_kstep, const bf16_t* __restrict__ Bt, int K, int tm, int tn, const Epi& epi, unsigned char* smem) {
    const int tid = threadIdx.x, lane = tid & 63, w = tid >> 6, wm = w >> 1, wn = w & 1, fr = lane & 15, fq = lane >> 4;
    const bf16_t* As = (const bf16_t*)smem;
    const size_t ldb_ = (size_t)K + 64;
    unsigned aoff[4], boff[4];
#pragma unroll
    for (int i = 0; i < 4; ++i) {
        const int row = 8 * (4 * w + i) + (lane >> 3), c = (lane & 7) ^ ((4 * i + (lane >> 4)) & 7);
        aoff[i] = (unsigned)((rm(tm * 128 + row) + c * 8) * 2);
        boff[i] = (unsigned)(((size_t)(tn * 128 + row) * ldb_ + c * 8) * 2);
    }
    const unsigned lds_u = (unsigned)(unsigned long long)(LAS unsigned char*)smem + (unsigned)(4 * w) * 1024u;
    unsigned la[2][4];
#pragma unroll
    for (int b_ = 0; b_ < 2; ++b_)
#pragma unroll
        for (int i = 0; i < 4; ++i) la[b_][i] = (unsigned)__builtin_amdgcn_readfirstlane((int)(lds_u + (unsigned)b_ * 32768u + (unsigned)i * 1024u));
#define GEMM_ISSUE(kt_, buf_) do { const bf16_t* ab_ = A + (long)(kt_) * a_kstep; const bf16_t* bb_ = Bt + (long)(kt_) * 64; \
        _Pragma("unroll") for (int i_ = 0; i_ < 4; ++i_) { glds16_s(ab_, aoff[i_], la[buf_][i_]); glds16_s(bb_, boff[i_], la[buf_][i_] + 16384u); } } while (0)
#define GEMM_ISSUE1(kt_, buf_, i_) do { glds16_s(A + (long)(kt_) * a_kstep, aoff[i_], la[buf_][i_]); glds16_s(Bt + (long)(kt_) * 64, boff[i_], la[buf_][i_] + 16384u); } while (0)
    f32x4 acc[4][4];
#pragma unroll
    for (int a = 0; a < 4; ++a)
#pragma unroll
        for (int b = 0; b < 4; ++b) acc[a][b] = (f32x4){0.f, 0.f, 0.f, 0.f};
    const int nk = K >> 6;
    const int fsw = (fr >> 1) & 7;
    __syncthreads();
    GEMM_ISSUE(0, 0);
    for (int kt = 0; kt < nk; ++kt) {
        asm volatile("s_waitcnt vmcnt(0)" ::: "memory");
        RAW_BARRIER();
        const bool nxt = kt + 1 < nk;
        const int bo = (kt & 1) * 16384;
#pragma unroll
        for (int ks = 0; ks < 2; ++ks) {
            bf16x8 af[4], bfr[4];
#pragma unroll
            for (int i = 0; i < 4; ++i) { af[i] = *(const bf16x8*)(As + bo + (wm * 64 + i * 16 + fr) * 64 + (((ks * 4 + fq) ^ fsw) * 8)); bfr[i] = *(const bf16x8*)(As + bo + 8192 + (wn * 64 + i * 16 + fr) * 64 + (((ks * 4 + fq) ^ fsw) * 8)); }
#pragma unroll
            for (int mi = 0; mi < 4; ++mi) {
#pragma unroll
                for (int ni = 0; ni < 4; ++ni) acc[mi][ni] = mfma16(bfr[ni], af[mi], acc[mi][ni]);
                if (ks == 0 && nxt) { if (kt & 1) GEMM_ISSUE1(kt + 1, 0, mi); else GEMM_ISSUE1(kt + 1, 1, mi); }
            }
        }
    }
#undef GEMM_ISSUE
#undef GEMM_ISSUE1
    epi(acc, tm * 128 + wm * 64, tn * 128 + wn * 64, fr, fq);
}

template <class Epi>
DEV void gemm_tile_big(long lda, const bf16_t* __restrict__ A, const bf16_t* __restrict__ Bt, int K, int tm, int tn, const Epi& epi, unsigned char* smem) {
    bf16_t* As = (bf16_t*)smem; bf16_t* Bs = As + 256 * 64;
    const int tid = threadIdx.x, lane = tid & 63, w = tid >> 6, wm = w >> 1, wn = w & 1, fr = lane & 15, fq = lane >> 4;
    const int c0_ = (tid & 7) * 8;
    const bf16_t* const ap0 = A + (long)(tm * 256 + (tid >> 3)) * lda + c0_;
    const long astep = 32 * lda;
    const size_t ldb_ = (size_t)K + 64;
    const bf16_t* const bp0 = Bt + (size_t)(tn * 128 + (tid >> 3)) * ldb_ + c0_;
    const size_t bstep = 32 * ldb_;
    f32x4 acc[2][4][4];
#pragma unroll
    for (int h = 0; h < 2; ++h)
#pragma unroll
        for (int a = 0; a < 4; ++a)
#pragma unroll
            for (int b = 0; b < 4; ++b) acc[h][a][b] = (f32x4){0.f, 0.f, 0.f, 0.f};
    u32x4 ra[8], rb[4];
    const int nk = K >> 6;
    const int sto = (tid >> 3) * 64 + (((tid & 7) ^ ((tid >> 4) & 7)) * 8);
    const int fsw = (fr >> 1) & 7;
#pragma unroll
    for (int i = 0; i < 8; ++i) ra[i] = *(const u32x4*)(ap0 + i * astep);
#pragma unroll
    for (int i = 0; i < 4; ++i) rb[i] = *(const u32x4*)(bp0 + i * bstep);
    for (int kt = 0; kt < nk; ++kt) {
        __syncthreads();
#pragma unroll
        for (int i = 0; i < 8; ++i) *(u32x4*)(As + sto + i * 32 * 64) = ra[i];
#pragma unroll
        for (int i = 0; i < 4; ++i) *(u32x4*)(Bs + sto + i * 32 * 64) = rb[i];
        __syncthreads();
        if (kt + 1 < nk) {
#pragma unroll
            for (int i = 0; i < 8; ++i) ra[i] = *(const u32x4*)(ap0 + i * astep + (kt + 1) * 64);
#pragma unroll
            for (int i = 0; i < 4; ++i) rb[i] = *(const u32x4*)(bp0 + i * bstep + (kt + 1) * 64);
        }
#pragma unroll
        for (int ks = 0; ks < 2; ++ks) {
            bf16x8 bfr[4];
#pragma unroll
            for (int i = 0; i < 4; ++i) bfr[i] = *(const bf16x8*)(Bs + (wn * 64 + i * 16 + fr) * 64 + (((ks * 4 + fq) ^ fsw) * 8));
#pragma unroll
            for (int h = 0; h < 2; ++h) {
                bf16x8 af[4];
#pragma unroll
                for (int i = 0; i < 4; ++i) af[i] = *(const bf16x8*)(As + (wm * 128 + h * 64 + i * 16 + fr) * 64 + (((ks * 4 + fq) ^ fsw) * 8));
#pragma unroll
                for (int mi = 0; mi < 4; ++mi)
#pragma unroll
                    for (int ni = 0; ni < 4; ++ni) acc[h][mi][ni] = mfma16(bfr[ni], af[mi], acc[h][mi][ni]);

            }
        }
    }
    epi(acc[0], tm * 256 + wm * 128, tn * 128 + wn * 64, fr, fq);
    epi(acc[1], tm * 256 + wm * 128 + 64, tn * 128 + wn * 64, fr, fq);
}

DEV void store_vt_tile(const f32x4 (&acc)[4][4], const float (&sc)[4], bf16_t* dst, long ldt, unsigned char* smem, int fr, int fq) {
    __syncthreads();
    bf16_t* L = (bf16_t*)smem + (threadIdx.x >> 6) * (64 * 72);
#pragma unroll
    for (int mi = 0; mi < 4; ++mi)
#pragma unroll
        for (int ni = 0; ni < 4; ++ni)
#pragma unroll
            for (int r = 0; r < 4; ++r) L[(ni * 16 + fq * 4 + r) * 72 + mi * 16 + fr] = f2bf(acc[mi][ni][r] * sc[mi]);
    const int lane = threadIdx.x & 63;
#pragma unroll
    for (int j = 0; j < 8; ++j) { const int q = lane + 64 * j, d = q >> 3, c = (q & 7) * 8; *(u32x4*)(dst + (long)d * ldt + c) = *(const u32x4*)(L + d * 72 + c); }
}

struct EpiInProj {
    const float* ss0; const float* qn; const float* kslcn; const float* kwinn; bf16_t* proj; bf16_t* vslt; bf16_t* vwt; float* gates; unsigned char* smem;
    DEV void operator()(f32x4 (&acc)[4][4], int row0, int col0, int fr, int fq) const {
        const int cb = col0 >> 6;
        if (cb >= 41) return;
#pragma unroll
        for (int mi = 0; mi < 4; ++mi) {
            const float rstd = rsqrtf(ss0[row0 + mi * 16 + fr] * (1.f / 1024.f) + EPS);
#pragma unroll
            for (int ni = 0; ni < 4; ++ni) acc[mi][ni] *= rstd;
        }
        const bool isq = cb < 16, isksl = (cb >= 24 && cb < 28), iskw = (cb >= 32 && cb < 36);
        if (isq || isksl || iskw) {
            const int dstcol = isq ? cb * 64 : (isksl ? 1536 + (cb - 24) * 64 : 1792 + (cb - 32) * 64);
            const float extra = isq ? QSCALE_NSA : 1.f;
#pragma unroll
            for (int mi = 0; mi < 4; ++mi) {
                float ss = 0.f;
#pragma unroll
                for (int ni = 0; ni < 4; ++ni) { const f32x4 v = acc[mi][ni]; ss += v[0] * v[0] + v[1] * v[1] + v[2] * v[2] + v[3] * v[3]; }
                ss = quad_sum(ss);
                const float r2 = rsqrtf(ss * (1.f / 64.f) + EPS) * extra;
                const long row = row0 + mi * 16 + fr;
#pragma unroll
                for (int ni = 0; ni < 4; ++ni) {
                    const f32x4 gq = *(const f32x4*)(qn + ni * 16 + fq * 4), gs = *(const f32x4*)(kslcn + ni * 16 + fq * 4), gw = *(const f32x4*)(kwinn + ni * 16 + fq * 4);
                    const f32x4 g4 = isq ? gq : (isksl ? gs : gw);
                    st_bf16x4(proj + row * 2048 + dstcol + ni * 16 + fq * 4, acc[mi][ni] * r2 * g4);
                }
            }
        } else if ((cb >= 16 && cb < 24)) {
            const int dstcol = 1024 + (cb - 16) * 64;
#pragma unroll
            for (int mi = 0; mi < 4; ++mi) { const long row = row0 + mi * 16 + fr;
#pragma unroll
                for (int ni = 0; ni < 4; ++ni) st_bf16x4(proj + row * 2048 + dstcol + ni * 16 + fq * 4, acc[mi][ni]); }
        } else if ((cb >= 28 && cb < 32) || (cb >= 36 && cb < 40)) {
            bf16_t* dst = cb < 32 ? vslt : vwt; const int g = cb < 32 ? cb - 28 : cb - 36;
            const int b = row0 >> 13, t0 = row0 & (T - 1);
            const float one4[4] = {1.f, 1.f, 1.f, 1.f};
            store_vt_tile(acc, one4, dst + ((long)((b * 4 + g) * 64)) * T + t0, T, smem, fr, fq);
        } else if (cb == 40) {
#pragma unroll
            for (int mi = 0; mi < 4; ++mi) { const long row = row0 + mi * 16 + fr;
#pragma unroll
                for (int ni = 0; ni < 3; ++ni) { f32x4 v = acc[mi][ni];
#pragma unroll
                    for (int r = 0; r < 4; ++r) v[r] = sigmoidf_(v[r]);
                    *(f32x4*)(gates + row * 48 + ni * 16 + fq * 4) = v; } }
        }
    }
};

struct EpiCmp1 {
    const float* b1; bf16_t* hid;
    DEV void operator()(f32x4 (&acc)[4][4], int row0, int col0, int fr, int fq) const {
#pragma unroll
        for (int ni = 0; ni < 4; ++ni) { const f32x4 bv = *(const f32x4*)(b1 + col0 + ni * 16 + fq * 4);
#pragma unroll
            for (int mi = 0; mi < 4; ++mi) { f32x4 v = acc[mi][ni] + bv;
#pragma unroll
                for (int r = 0; r < 4; ++r) { const float x = v[r]; const float u = 0.7978845608028654f * (x + 0.044715f * x * x * x); v[r] = x * sigmoidf_(2.f * u); }
                st_bf16x4(hid + (long)(row0 + mi * 16 + fr) * 256 + col0 + ni * 16 + fq * 4, v); } }
    }
};

struct EpiCmp2 {
    int which; const float* gain; bf16_t* kcmp; bf16_t* vcmpt;
    DEV void operator()(f32x4 (&acc)[4][4], int row0, int col0, int fr, int fq) const {
        if (col0 != 0) return;
        if (which == 0) {
#pragma unroll
            for (int mi = 0; mi < 4; ++mi) {
                float ss = 0.f;
#pragma unroll
                for (int ni = 0; ni < 4; ++ni) { const f32x4 v = acc[mi][ni]; ss += v[0] * v[0] + v[1] * v[1] + v[2] * v[2] + v[3] * v[3]; }
                ss = quad_sum(ss);
                const float r2 = rsqrtf(ss * (1.f / 64.f) + EPS);
                const long row = row0 + mi * 16 + fr;
#pragma unroll
                for (int ni = 0; ni < 4; ++ni) { const f32x4 g4 = *(const f32x4*)(gain + ni * 16 + fq * 4); st_bf16x4(kcmp + row * 64 + ni * 16 + fq * 4, acc[mi][ni] * r2 * g4); }
            }
        } else {
#pragma unroll
            for (int mi = 0; mi < 4; ++mi) { const int row = row0 + mi * 16 + fr, bg = row >> 9, j = row & 511;
#pragma unroll
                for (int ni = 0; ni < 4; ++ni)
#pragma unroll
                    for (int r = 0; r < 4; ++r) vcmpt[((long)(bg * 64 + ni * 16 + fq * 4 + r)) * 512 + j] = f2bf(acc[mi][ni][r]); }
        }
    }
};

struct EpiResid {
    const float* base; float* out; bf16_t* xb; float* ssn;
    DEV void operator()(f32x4 (&acc)[4][4], int row0, int col0, int fr, int fq) const {
#pragma unroll
        for (int mi = 0; mi < 4; ++mi) {
            const long row = row0 + mi * 16 + fr; float ss = 0.f;
#pragma unroll
            for (int ni = 0; ni < 4; ++ni) {
                const long off = row * 1024 + col0 + ni * 16 + fq * 4;
                const f32x4 v = *(const f32x4*)(base + off) + acc[mi][ni];
                *(f32x4*)(out + off) = v;
                if (ssn) { st_bf16x4(xb + row * XBLD + col0 + ni * 16 + fq * 4, v); ss += v[0] * v[0] + v[1] * v[1] + v[2] * v[2] + v[3] * v[3]; }
            }
            if (ssn) { ss = quad_sum(ss); if (fq == 0) atomicAdd(ssn + row, ss); }
        }
    }
};

struct EpiGateUp {
    const float* ss; bf16_t* hbuf;
    DEV void operator()(f32x4 (&acc)[4][4], int row0, int col0, int fr, int fq) const {
        const int hc0 = (col0 >> 7) * 64 + ((col0 >> 6) & 1) * 32;
#pragma unroll
        for (int mi = 0; mi < 4; ++mi) {
            const long row = row0 + mi * 16 + fr;
            const float rstd = rsqrtf(ss[row] * (1.f / 1024.f) + EPS);
#pragma unroll
            for (int ni = 0; ni < 2; ++ni) {
                f32x4 g = acc[mi][ni] * rstd, u = acc[mi][ni + 2] * rstd, h;
#pragma unroll
                for (int r = 0; r < 4; ++r) h[r] = g[r] * sigmoidf_(g[r]) * u[r];
                st_bf16x4(hbuf + row * 2816 + hc0 + ni * 16 + fq * 4, h);
            }
        }
    }
};

struct EpiKvqa {
    const float* ss; bf16_t* kva; float* ssc; float* ssq;
    DEV void operator()(f32x4 (&acc)[4][4], int row0, int col0, int fr, int fq) const {
        const int cb = col0 >> 6;
        if (cb >= 11) return;
#pragma unroll
        for (int mi = 0; mi < 4; ++mi) {
            const long row = row0 + mi * 16 + fr;
            const float rstd = rsqrtf(ss[row] * (1.f / 1024.f) + EPS);
            float s2 = 0.f;
#pragma unroll
            for (int ni = 0; ni < 4; ++ni) { const f32x4 v = acc[mi][ni] * rstd; s2 += v[0] * v[0] + v[1] * v[1] + v[2] * v[2] + v[3] * v[3];
                st_bf16x4(kva + row * 768 + col0 + ni * 16 + fq * 4, v); }
            s2 = quad_sum(s2);
            if (fq == 0) { if (cb < 4) atomicAdd(ssc + row, s2); else if (cb >= 5) atomicAdd(ssq + row, s2); }
        }
    }
};

struct EpiKvb {
    const float* ssc; bf16_t* kbuf; bf16_t* vt; unsigned char* smem;
    DEV void operator()(f32x4 (&acc)[4][4], int row0, int col0, int fr, int fq) const {
        const int cb = col0 >> 6, h = cb >> 2, sub = cb & 3;
        float rstd[4];
#pragma unroll
        for (int mi = 0; mi < 4; ++mi) rstd[mi] = rsqrtf(ssc[row0 + mi * 16 + fr] * (1.f / 256.f) + EPS);
        if (sub < 2) {
#pragma unroll
            for (int mi = 0; mi < 4; ++mi)
#pragma unroll
                for (int ni = 0; ni < 4; ++ni) st_bf16x4(kbuf + (long)(row0 + mi * 16 + fr) * 1536 + h * 192 + sub * 64 + ni * 16 + fq * 4, acc[mi][ni] * rstd[mi]);
        } else {
            const int b = row0 >> 13, t0 = row0 & (T - 1);
            store_vt_tile(acc, rstd, vt + ((long)((b * 8 + h) * 128 + (sub - 2) * 64)) * T + t0, T, smem, fr, fq);
        }
    }
};

struct EpiQb {
    const float* ssq; bf16_t* qbuf;
    DEV void operator()(f32x4 (&acc)[4][4], int row0, int col0, int fr, int fq) const {
#pragma unroll
        for (int mi = 0; mi < 4; ++mi) {
            const long row = row0 + mi * 16 + fr;
            const float rstd = rsqrtf(ssq[row] * (1.f / 384.f) + EPS);
#pragma unroll
            for (int ni = 0; ni < 4; ++ni) st_bf16x4(qbuf + row * 1536 + col0 + ni * 16 + fq * 4, acc[mi][ni] * rstd);
        }
    }
};


template <int MODE, bool MASK>
DEV void nsa_compute(const LAS unsigned char* Ks, const LAS unsigned char* Vs, int tt, const bf16x8 (&qf)[2], int t, const f32x4 (&bias)[4], float dl, bool selbit,
                     float& l, float invl, f32x4 (&O)[4], f32x4& lacc, float* IA, float& carry, int tokl, int fr, int fq) {
    const int fsw = (fr >> 1) & 7;
    f32x4 s[4];
#pragma unroll
    for (int k16 = 0; k16 < 4; ++k16) {
        s[k16] = bias[k16];
#pragma unroll
        for (int ks = 0; ks < 2; ++ks) { const bf16x8 kf = *(const LAS bf16x8*)(Ks + (k16 * 16 + fr) * 128 + (((ks * 4 + fq) ^ fsw) * 16)); s[k16] = mfma16(kf, qf[ks], s[k16]); }
    }
    if (MASK) {
#pragma unroll
        for (int k16 = 0; k16 < 4; ++k16)
#pragma unroll
            for (int r = 0; r < 4; ++r) {
                const int e = tt * 64 + k16 * 16 + fq * 4 + r;
                bool valid;
                if (MODE <= 1) valid = (16 * e + 31 <= t);
                else if (MODE == 2) valid = (e <= t);
                else valid = (e <= t) && (t - e < 512);
                s[k16][r] = valid ? s[k16][r] : -INFINITY;
            }
    }
    float sh = dl;
    if (MODE == 2) sh = selbit ? dl : -INFINITY;
    if (MODE == 1) sh = dl + invl;
    if (MODE == 0) {
        float ps = 0.f;
#pragma unroll
        for (int k16 = 0; k16 < 4; ++k16)
#pragma unroll
            for (int r = 0; r < 4; ++r) ps += fexp2(s[k16][r] + sh);
        l += ps;
        return;
    }
    {
        float ps = 0.f;
#pragma unroll
        for (int k16 = 0; k16 < 4; ++k16)
#pragma unroll
            for (int r = 0; r < 4; ++r) s[k16][r] = fexp2(s[k16][r] + sh);
        (void)ps;
    }
    if (MODE == 1) {
        const int lane = fq * 16 + fr;
#pragma unroll
        for (int k16 = 0; k16 < 4; ++k16) {
            f32x4 v = s[k16];
#pragma unroll
            for (int r = 0; r < 4; ++r) { DPP_ADD(v[r], 0xB1); DPP_ADD(v[r], 0x4E); }
            const float y = __shfl(v[3], (lane + 48) & 63);
            const float prev = fq > 0 ? y : carry;
            carry = y;
            if ((fr & 3) == 0) IA[tokl * 132 + tt * 16 + k16 * 4 + fq] = ((v[0] + v[1]) + (v[2] + v[3])) + prev;
        }
    }
#pragma unroll
    for (int ks2 = 0; ks2 < 2; ++ks2) {
        u32x4 pu;
        pu.x = pk_bf16(s[2 * ks2][0], s[2 * ks2][1]); pu.y = pk_bf16(s[2 * ks2][2], s[2 * ks2][3]);
        pu.z = pk_bf16(s[2 * ks2 + 1][0], s[2 * ks2 + 1][1]); pu.w = pk_bf16(s[2 * ks2 + 1][2], s[2 * ks2 + 1][3]);
        const bf16x8 pb = __builtin_bit_cast(bf16x8, pu);
        if (MODE >= 2) { u32x4 ou; ou.x = 0x3F803F80u; ou.y = 0x3F803F80u; ou.z = 0x3F803F80u; ou.w = 0x3F803F80u; lacc = mfma16(__builtin_bit_cast(bf16x8, ou), pb, lacc); }
#pragma unroll
        for (int dt = 0; dt < 4; ++dt) {
            const LAS unsigned char* vr = Vs + (dt * 16 + fr) * 128 + (fq & 1) * 8;
            const u32x2 v0 = *(const LAS u32x2*)(vr + (((ks2 * 4 + (fq >> 1)) ^ fsw) * 16));
            const u32x2 v1 = *(const LAS u32x2*)(vr + (((ks2 * 4 + (fq >> 1) + 2) ^ fsw) * 16));
            u32x4 vv; vv.x = v0.x; vv.y = v0.y; vv.z = v1.x; vv.w = v1.y;
            O[dt] = mfma16(__builtin_bit_cast(bf16x8, vv), pb, O[dt]);
        }
    }
}

DEV int take_bit_hi(u64& lo, u64& hi) {
    const bool usehi = hi != 0ull;
    const u64 v = usehi ? hi : lo;
    if (v == 0ull) return -1;
    const int b = 63 - __builtin_clzll(v);
    const u64 nv = v & ~(1ull << b);
    hi = usehi ? nv : hi; lo = usehi ? lo : nv;
    return b + (usehi ? 64 : 0);
}
template <int MODE> DEV int take_tile(u64& lo, u64& hi) { if (MODE >= 2) return take_bit_hi(lo, hi); else return take_bit(lo, hi); }

template <int MODE>
DEV void nsa_branch(u64 mlo, u64 mhi, u64 wlo, u64 whi, const bf16_t* kbase, long ktstride, long krs, const bf16_t* vbase, long vrs,
                    LAS unsigned char* ring, const bf16x8 (&qf)[2], int t, int s0, const f32x4 (&bias)[4], float slope2, float cadj, u64 tm0, u64 tm1,
                    float& l, float invl, f32x4 (&O)[4], f32x4& lacc, float* IA, int tokl, int fr, int fq, int abl = 0) {
    const int tid = threadIdx.x, lane = tid & 63, w = tid >> 6;
    const int t0 = take_tile<MODE>(mlo, mhi);
    if (t0 < 0) return;
    unsigned koff[2], voff[2];
#pragma unroll
    for (int j = 0; j < 2; ++j) { const int row = 8 * (w * 2 + j) + (lane >> 3), c = (lane & 7) ^ (((lane >> 4) + 4 * j) & 7); koff[j] = (unsigned)(((long)row * krs + c * 8) * 2); voff[j] = (unsigned)(((long)row * vrs + c * 8) * 2); }
    const unsigned ring_u = (unsigned)(unsigned long long)ring + (unsigned)(w * 2) * 1024u;
#define NSA_ISSUE(tt_, slot_) do { const bf16_t* kb_ = kbase + (long)(tt_) * ktstride; const bf16_t* vb_ = vbase + (long)(tt_) * 64; \
        _Pragma("unroll") for (int j_ = 0; j_ < 2; ++j_) { \
            const unsigned la_ = (unsigned)__builtin_amdgcn_readfirstlane((int)(ring_u + (unsigned)(slot_) * 16384u + (unsigned)j_ * 1024u)); \
            glds16_s(kb_, koff[j_], la_); if (MODE != 0) glds16_s(vb_, voff[j_], la_ + 8192u); } } while (0)
    const int t1 = take_tile<MODE>(mlo, mhi);
    NSA_ISSUE(t0, 0);
    if (t1 >= 0) NSA_ISSUE(t1, 1);
    int cur = t0, nxt = t1, slot = 0;
    float carry = 0.f;
    while (true) {
        const int nn = (nxt >= 0) ? take_tile<MODE>(mlo, mhi) : -1;
        if (nxt >= 0) { if (MODE == 0) asm volatile("s_waitcnt vmcnt(2)" ::: "memory"); else asm volatile("s_waitcnt vmcnt(4)" ::: "memory"); } else asm volatile("s_waitcnt vmcnt(0)" ::: "memory");
        RAW_BARRIER();
        if (nn >= 0) NSA_ISSUE(nn, (slot == 0 ? 2 : slot - 1));
        const bool wact = (((cur < 64 ? wlo : whi) >> (cur & 63)) & 1ull) != 0ull;
        if (wact && !(abl & 16)) {
            const bool selbit = (((cur < 64 ? tm0 : tm1) >> (cur & 63)) & 1ull) != 0ull;
            bool needmask; float dl;
            if (MODE <= 1) { needmask = 16 * (64 * cur + 63) + 31 > s0; dl = slope2 * (float)(1024 * cur - s0) + cadj; }
            else if (MODE == 2) { needmask = 64 * cur + 63 > s0; dl = slope2 * (float)(64 * cur - s0) + cadj; }
            else { needmask = (64 * cur + 63 > s0) || (64 * cur < s0 + 15 - 511); dl = slope2 * (float)(64 * cur - s0) + cadj; }
            if (needmask) nsa_compute<MODE, true>(ring + slot * 16384, ring + slot * 16384 + 8192, cur, qf, t, bias, dl, selbit, l, invl, O, lacc, IA, carry, tokl, fr, fq);
            else nsa_compute<MODE, false>(ring + slot * 16384, ring + slot * 16384 + 8192, cur, qf, t, bias, dl, selbit, l, invl, O, lacc, IA, carry, tokl, fr, fq);
        }
        if (nxt < 0) break;
        cur = nxt; nxt = nn; slot = (slot == 2 ? 0 : slot + 1);
    }
    RAW_BARRIER();
#undef NSA_ISSUE
}

DEV void nsa_item(const Params& p, unsigned char* smem, int bg, int s0, float Cc, float Cs, float cadj_w) {
    LAS unsigned char* ring = (LAS unsigned char*)smem;
    float* IA = (float*)(smem + 49152);
    u64* SELM = (u64*)(smem + 49152 + 16 * 132 * 4);
    const bf16_t* proj = (const bf16_t*)(p.ws + OFF_PROJ);
    const bf16_t* kcmp = (const bf16_t*)(p.ws + OFF_KCMP); const bf16_t* vcmpt = (const bf16_t*)(p.ws + OFF_VCMPT);
    const bf16_t* vslt = (const bf16_t*)(p.ws + OFF_VSLT); const bf16_t* vwt = (const bf16_t*)(p.ws + OFF_VWT);
    const float* gates = (const float*)(p.ws + OFF_GATES);
    bf16_t* obuf = (bf16_t*)(p.ws + OFF_OBUF);
    const int b = bg >> 2, g = bg & 3;
    const int tid = threadIdx.x, lane = tid & 63, w = tid >> 6, fr = lane & 15, fq = lane >> 4;
    const int tokl = w * 4 + (fr >> 2), t = s0 + tokl, head = g * 4 + (fr & 3);
    const float slope2 = exp2f(-0.5f * (float)(head + 1)) * LOG2E;
    const long row = (long)b * T + t;
    bf16x8 qf[2];
#pragma unroll
    for (int ks = 0; ks < 2; ++ks) qf[ks] = *(const bf16x8*)(proj + row * 2048 + head * 64 + ks * 32 + fq * 8);
    f32x4 bias[4];
#pragma unroll
    for (int k16 = 0; k16 < 4; ++k16)
#pragma unroll
        for (int r = 0; r < 4; ++r) bias[k16][r] = slope2 * ((float)(16 * (k16 * 16 + fq * 4 + r)) + 15.5f - (float)tokl) - Cc;
    float g0 = gates[row * 48 + head * 3 + 0], g1 = gates[row * 48 + head * 3 + 1], g2 = gates[row * 48 + head * 3 + 2];
    asm volatile("" : "+v"(qf[0]), "+v"(qf[1]), "+v"(g0), "+v"(g1), "+v"(g2));
    for (int i = tid; i < 16 * 132; i += 256) IA[i] = 0.f;
    __syncthreads();
    const u64 FULL = ~0ull;
    const int nc = ((s0 >> 4) + 63) >> 6;
    const u64 clo = nc ? ((1ull << nc) - 1ull) : 0ull;
    float l = 0.f;
    f32x4 O[4], lacc = (f32x4){0.f, 0.f, 0.f, 0.f};
#pragma unroll
    for (int dt = 0; dt < 4; ++dt) O[dt] = (f32x4){0.f, 0.f, 0.f, 0.f};
    const bf16_t* kcb = kcmp + (long)bg * 512 * 64; const bf16_t* vcb = vcmpt + (long)bg * 64 * 512;
    if (!(p.abl & 1)) {
    nsa_branch<0>(clo, 0ull, FULL, FULL, kcb, 64 * 64, 64, vcb, 512, ring, qf, t, s0, bias, slope2, 0.f, 0ull, 0ull, l, 0.f, O, lacc, IA, tokl, fr, fq);
    l = quad_sum(l);
    float invl_c = l > 0.f ? -__log2f(l) : -INFINITY;
    nsa_branch<1>(clo, 0ull, FULL, FULL, kcb, 64 * 64, 64, vcb, 512, ring, qf, t, s0, bias, slope2, 0.f, 0ull, 0ull, l, invl_c, O, lacc, IA, tokl, fr, fq);
    }
    f32x4 outacc[4];
#pragma unroll
    for (int dt = 0; dt < 4; ++dt) outacc[dt] = O[dt] * g0;
    __syncthreads();
    if (!(p.abl & 2)) {
#pragma unroll
    for (int k = 0; k < 4; ++k) {
        const int tk = w * 4 + k, tt_ = s0 + tk, curb = tt_ >> 6;
#pragma unroll
        for (int hh = 0; hh < 2; ++hh) {
            const int blk = lane + 64 * hh;
            const float imp = IA[tk * 132 + blk];
            const bool valid = blk <= curb, forced = (blk == 0) || (blk == curb) || (blk == curb - 1);
            IA[tk * 132 + blk] = valid ? imp + (forced ? 1e4f : 0.f) : -1.f;
        }
    }
    __syncthreads();
    {
        unsigned ka[4], kb[4], th[4];
#pragma unroll
        for (int k = 0; k < 4; ++k) {
            const int tk = w * 4 + k;
            const float a = IA[tk * 132 + lane], bsc = IA[tk * 132 + lane + 64];
            ka[k] = a >= 0.f ? __float_as_uint(a) + 1u : 0u; kb[k] = bsc >= 0.f ? __float_as_uint(bsc) + 1u : 0u; th[k] = 0u;
        }
#pragma unroll 1
        for (int bit = 30; bit >= 0; --bit) {
#pragma unroll
            for (int k = 0; k < 4; ++k) {
                const unsigned cand = th[k] | (1u << bit);
                const int c = __builtin_popcountll(__ballot(ka[k] >= cand)) + __builtin_popcountll(__ballot(kb[k] >= cand));
                th[k] = c >= 16 ? cand : th[k];
            }
        }
#pragma unroll
        for (int k = 0; k < 4; ++k) {
            const int tk = w * 4 + k;
            u64 m0, m1;
            if (th[k] == 0u) { m0 = __ballot(ka[k] > 0u); m1 = __ballot(kb[k] > 0u); }
            else {
                m0 = __ballot(ka[k] > th[k]); m1 = __ballot(kb[k] > th[k]);
                u64 e0 = __ballot(ka[k] == th[k]), e1 = __ballot(kb[k] == th[k]);
                int need = 16 - (__builtin_popcountll(m0) + __builtin_popcountll(m1));
                while (need > 0 && (e0 | e1)) {
                    if (e0) { const u64 bt = e0 & (0ull - e0); m0 |= bt; e0 ^= bt; } else { const u64 bt = e1 & (0ull - e1); m1 |= bt; e1 ^= bt; }
                    --need;
                }
            }
            if (lane == 0) { SELM[tk * 2 + 0] = m0; SELM[tk * 2 + 1] = m1; }
        }
    }
    __syncthreads();
    }
    u64 ulo = 0, uhi = 0, wlo = 0, whi = 0;
    for (int k = 0; k < 16; ++k) { const u64 a = SELM[k * 2], bb = SELM[k * 2 + 1]; ulo |= a; uhi |= bb; if ((k >> 2) == w) { wlo |= a; whi |= bb; } }
    ulo = uni64(ulo); uhi = uni64(uhi); wlo = uni64(wlo); whi = uni64(whi);
    const u64 tm0 = SELM[tokl * 2], tm1 = SELM[tokl * 2 + 1];
    const bf16_t* pb_ = proj + (long)b * T * 2048 + g * 64;
#pragma unroll
    for (int k16 = 0; k16 < 4; ++k16)
#pragma unroll
        for (int r = 0; r < 4; ++r) bias[k16][r] = slope2 * (float)(k16 * 16 + fq * 4 + r - tokl) - Cs;
    {
        lacc = (f32x4){0.f, 0.f, 0.f, 0.f};
#pragma unroll
        for (int dt = 0; dt < 4; ++dt) O[dt] = (f32x4){0.f, 0.f, 0.f, 0.f};
        if (!(p.abl & 4)) nsa_branch<2>(ulo, uhi, wlo, whi, pb_ + 1536, 64 * 2048, 2048, vslt + (long)bg * 64 * T, T, ring, qf, t, s0, bias, slope2, 0.f, tm0, tm1, l, 0.f, O, lacc, IA, tokl, fr, fq, p.abl);
        const float sc = (lacc[0] > 0.f ? 1.f / lacc[0] : 0.f) * g1;
#pragma unroll
        for (int dt = 0; dt < 4; ++dt) outacc[dt] += O[dt] * sc;
    }
    {
        const int wfirst = (s0 > 511 ? s0 - 511 : 0) >> 6, wlast = (s0 + 15) >> 6;
        u64 qlo = 0, qhi = 0;
        for (int i = wfirst; i <= wlast; ++i) { if (i < 64) qlo |= 1ull << i; else qhi |= 1ull << (i - 64); }
        lacc = (f32x4){0.f, 0.f, 0.f, 0.f};
#pragma unroll
        for (int dt = 0; dt < 4; ++dt) O[dt] = (f32x4){0.f, 0.f, 0.f, 0.f};
        if (!(p.abl & 8)) nsa_branch<3>(qlo, qhi, FULL, FULL, pb_ + 1792, 64 * 2048, 2048, vwt + (long)bg * 64 * T, T, ring, qf, t, s0, bias, slope2, cadj_w, 0ull, 0ull, l, 0.f, O, lacc, IA, tokl, fr, fq, p.abl);
        const float sc = (lacc[0] > 0.f ? 1.f / lacc[0] : 0.f) * g2;
#pragma unroll
        for (int dt = 0; dt < 4; ++dt) outacc[dt] += O[dt] * sc;
    }
#pragma unroll
    for (int dt = 0; dt < 4; ++dt) st_bf16x4(obuf + row * OBLD + head * 64 + dt * 16 + fq * 4, outacc[dt]);
    __syncthreads();
}

DEV void phase_nsa(const Params& p, unsigned char* smem) {
    const int nitems = 4096, G = gridDim.x;
    float Cc, Cs, cadj_w;
    {
        const int lane = threadIdx.x & 63;
        float gq = fabsf(p.in[IN_A_Q_NORM][lane]), gc = fabsf(p.in[IN_A_KCMP_NORM][lane]), gs = fabsf(p.in[IN_A_KSLC_NORM][lane]), gw = fabsf(p.in[IN_A_KWIN_NORM][lane]);
        for (int o = 1; o < 64; o <<= 1) { gq = fmaxf(gq, __shfl_xor(gq, o)); gc = fmaxf(gc, __shfl_xor(gc, o)); gs = fmaxf(gs, __shfl_xor(gs, o)); gw = fmaxf(gw, __shfl_xor(gw, o)); }
        const float k_ = 64.f * QSCALE_NSA * 1.02f * gq;
        Cc = fminf(k_ * gc + 0.5f, 40.f); Cs = fminf(k_ * gs + 0.5f, 40.f); cadj_w = Cs - fminf(k_ * gw + 0.5f, 40.f);
        Cc = __uint_as_float(__builtin_amdgcn_readfirstlane(__float_as_uint(Cc))); Cs = __uint_as_float(__builtin_amdgcn_readfirstlane(__float_as_uint(Cs)));
        cadj_w = __uint_as_float(__builtin_amdgcn_readfirstlane(__float_as_uint(cadj_w)));
    }
    for (int rr = 0; rr * G < nitems; ++rr) {
        const int idx = (rr & 1) ? (rr + 1) * G - 1 - (int)blockIdx.x : rr * G + (int)blockIdx.x;
        if (idx >= nitems) continue;
        nsa_item(p, smem, idx & 7, (511 - (idx >> 3)) * 16, Cc, Cs, cadj_w);
    }
}

DEV void phase_finish(const Params& p) {
    bf16_t* Kb = (bf16_t*)(p.ws + OFF_K); bf16_t* Qb = (bf16_t*)(p.ws + OFF_Q); const bf16_t* kva = (const bf16_t*)(p.ws + OFF_KVA);
    const float* kn = p.in[IN_KV_K_NORM]; const float* qn = p.in[IN_B_Q_NORM];
    const int tid = threadIdx.x, lane = tid & 63;
    const float inv = (float)pow(10000.0, -(double)(lane & 31) / 32.0);
    const float kn0 = kn[2 * lane], kn1 = kn[2 * lane + 1], kn2 = kn[128 + lane];
    const float qn0 = qn[2 * lane], qn1 = qn[2 * lane + 1], qn2 = qn[128 + lane];
    for (int row = blockIdx.x * 4 + (tid >> 6); row < M; row += gridDim.x * 4) {
        const int t = row & (T - 1);
        const float ang = (float)t * inv;
        const double rev = (double)ang * 0.15915494309189535;
        const float frac = (float)(rev - rint(rev));
        const float cs = __builtin_amdgcn_cosf(frac), sn = __builtin_amdgcn_sinf(frac);
        const float pe = bf2f(kva[(long)row * 768 + 256 + lane]);
        const float pess = wave_sum(pe * pe);
#pragma unroll
        for (int h = 0; h < 8; ++h) {
            {
                bf16_t* kp = Kb + (long)row * 1536 + h * 192;
                const unsigned raw = *(const unsigned*)(kp + 2 * lane);
                float a = __uint_as_float(raw << 16), bq = __uint_as_float(raw & 0xffff0000u);
                const float ss = wave_sum(a * a + bq * bq) + pess;
                const float rs = rsqrtf(ss * (1.f / 192.f) + EPS);
                a *= rs * kn0; bq *= rs * kn1;
                const float x = pe * rs * kn2, xo = __shfl_xor(x, 32);
                const float o = lane < 32 ? x * cs - xo * sn : xo * sn + x * cs;
                *(unsigned*)(kp + 2 * lane) = pk_bf16(a, bq);
                kp[128 + lane] = f2bf(o);
            }
            {
                bf16_t* qp = Qb + (long)row * 1536 + h * 192;
                const unsigned raw = *(const unsigned*)(qp + 2 * lane);
                float a = __uint_as_float(raw << 16), bq = __uint_as_float(raw & 0xffff0000u);
                float x = bf2f(qp[128 + lane]);
                const float ss = wave_sum(a * a + bq * bq + x * x);
                const float rs = rsqrtf(ss * (1.f / 192.f) + EPS);
                a *= rs * qn0 * QSCALE_MLA; bq *= rs * qn1 * QSCALE_MLA;
                x *= rs * qn2 * QSCALE_MLA;
                const float xo = __shfl_xor(x, 32);
                const float o = lane < 32 ? x * cs - xo * sn : xo * sn + x * cs;
                *(unsigned*)(qp + 2 * lane) = pk_bf16(a, bq);
                qp[128 + lane] = f2bf(o);
            }
        }
    }
}

constexpr int MLA_QT = 2;
DEV void mla_item(const Params& p, unsigned char* smem, int bh, int qb, float negC) {
    const bf16_t* Kb = (const bf16_t*)(p.ws + OFF_K); const bf16_t* Qb = (const bf16_t*)(p.ws + OFF_Q); const bf16_t* VT = (const bf16_t*)(p.ws + OFF_VT);
    bf16_t* obuf = (bf16_t*)(p.ws + OFF_OBUF);
    const int b = bh >> 3, h = bh & 7, q0 = qb * (64 * MLA_QT);
    const int tid = threadIdx.x, lane = tid & 63, w = tid >> 6, fr = lane & 15, fq = lane >> 4;
    const int wq0 = q0 + w * (16 * MLA_QT);
    bf16x8 qf[MLA_QT][6];
#pragma unroll
    for (int qt = 0; qt < MLA_QT; ++qt)
#pragma unroll
        for (int ks = 0; ks < 6; ++ks) qf[qt][ks] = *(const bf16x8*)(Qb + ((long)b * T + wq0 + qt * 16 + fr) * 1536 + h * 192 + ks * 32 + fq * 8);
#pragma unroll
    for (int qt = 0; qt < MLA_QT; ++qt) asm volatile("" : "+v"(qf[qt][0]), "+v"(qf[qt][1]), "+v"(qf[qt][2]), "+v"(qf[qt][3]), "+v"(qf[qt][4]), "+v"(qf[qt][5]));
    f32x4 O[MLA_QT][8];
    f32x4 lacc[MLA_QT];
    u32x4 ones_u; ones_u.x = 0x3F803F80u; ones_u.y = 0x3F803F80u; ones_u.z = 0x3F803F80u; ones_u.w = 0x3F803F80u;
    const bf16x8 ones = __builtin_bit_cast(bf16x8, ones_u);
#pragma unroll
    for (int qt = 0; qt < MLA_QT; ++qt) { lacc[qt] = (f32x4){0.f, 0.f, 0.f, 0.f};
#pragma unroll
        for (int dt = 0; dt < 8; ++dt) O[qt][dt] = (f32x4){0.f, 0.f, 0.f, 0.f}; }
    const int nkt = (q0 + 64 * MLA_QT) / 64;
    const bf16_t* kg = Kb + (long)b * T * 1536 + h * 192;
    const bf16_t* vg = VT + (long)(b * 8 + h) * 128 * T;
    unsigned koff[6], voff[4];
#pragma unroll
    for (int i = 0; i < 6; ++i) { const int q = (6 * w + i) * 64 + lane, r = q / 24, cp = q % 24, c = (cp & ~7) | ((cp & 7) ^ ((r >> 1) & 7)); koff[i] = (unsigned)((r * 1536 + c * 8) * 2); }
#pragma unroll
    for (int i = 0; i < 4; ++i) { const int r = 8 * (4 * w + i) + (lane >> 3), c = (lane & 7) ^ ((r >> 1) & 7); voff[i] = (unsigned)(((long)r * T + c * 8) * 2); }
    const unsigned lds_u = (unsigned)(unsigned long long)(LAS unsigned char*)smem;
    unsigned lk[2][6], lv[4];
#pragma unroll
    for (int bb = 0; bb < 2; ++bb)
#pragma unroll
        for (int i = 0; i < 6; ++i) lk[bb][i] = (unsigned)__builtin_amdgcn_readfirstlane((int)(lds_u + (unsigned)bb * 24576u + (unsigned)(6 * w + i) * 1024u));
#pragma unroll
    for (int i = 0; i < 4; ++i) lv[i] = (unsigned)__builtin_amdgcn_readfirstlane((int)(lds_u + 49152u + (unsigned)(4 * w + i) * 1024u));
#define MLA_ISSUE_K(kt_, buf_) do { const bf16_t* kb_ = kg + (long)(kt_) * 64 * 1536; _Pragma("unroll") for (int i_ = 0; i_ < 6; ++i_) glds16_s(kb_, koff[i_], lk[buf_][i_]); } while (0)
#define MLA_ISSUE_V(kt_) do { const bf16_t* vb_ = vg + (long)(kt_) * 64; _Pragma("unroll") for (int i_ = 0; i_ < 4; ++i_) glds16_s(vb_, voff[i_], lv[i_]); } while (0)
    const int fsw = (fr >> 1) & 7;
    __syncthreads();
    MLA_ISSUE_K(0, 0);
    for (int kt = 0; kt < nkt; ++kt) {
        asm volatile("s_waitcnt vmcnt(0)" ::: "memory");
        RAW_BARRIER();
        MLA_ISSUE_V(kt);
        const bool more = kt + 1 < nkt;
        if (more) { if (kt & 1) MLA_ISSUE_K(kt + 1, 0); else MLA_ISSUE_K(kt + 1, 1); }
        const bool active = !(kt * 64 > wq0 + 16 * MLA_QT - 1);
        const unsigned char* Ks = smem + (kt & 1) * 24576;
        const unsigned char* Vs = smem + 49152;
        f32x4 s[MLA_QT][4];
        bf16x8 pb[MLA_QT][2];
        if (active) {
            __builtin_amdgcn_s_setprio(1);
#pragma unroll
            for (int k16 = 0; k16 < 4; ++k16) {
                _Pragma("unroll") for (int qt = 0; qt < MLA_QT; ++qt) s[qt][k16] = (f32x4){negC, negC, negC, negC};
#pragma unroll
                for (int ks = 0; ks < 6; ++ks) {
                    const int c = ks * 4 + fq;
                    const bf16x8 kf = *(const bf16x8*)(Ks + (k16 * 16 + fr) * 384 + (((c & ~7) | ((c & 7) ^ fsw)) * 16));
#pragma unroll
                    for (int qt = 0; qt < MLA_QT; ++qt) s[qt][k16] = mfma16(kf, qf[qt][ks], s[qt][k16]);
                }
            }
            __builtin_amdgcn_s_setprio(0);
            const bool needmask = kt * 64 + 63 > wq0;
#pragma unroll
            for (int qt = 0; qt < MLA_QT; ++qt) {
                if (needmask) {
                    const int qpos = wq0 + qt * 16 + fr;
#pragma unroll
                    for (int k16 = 0; k16 < 4; ++k16)
#pragma unroll
                        for (int r = 0; r < 4; ++r) { const int key = kt * 64 + k16 * 16 + fq * 4 + r; if (key > qpos) s[qt][k16][r] = -INFINITY; }
                }
#pragma unroll
                for (int k16 = 0; k16 < 4; ++k16)
#pragma unroll
                    for (int r = 0; r < 4; ++r) s[qt][k16][r] = fexp2(s[qt][k16][r]);
#pragma unroll
                for (int ks2 = 0; ks2 < 2; ++ks2) {
                    u32x4 pu;
                    pu.x = pk_bf16(s[qt][2 * ks2][0], s[qt][2 * ks2][1]); pu.y = pk_bf16(s[qt][2 * ks2][2], s[qt][2 * ks2][3]);
                    pu.z = pk_bf16(s[qt][2 * ks2 + 1][0], s[qt][2 * ks2 + 1][1]); pu.w = pk_bf16(s[qt][2 * ks2 + 1][2], s[qt][2 * ks2 + 1][3]);
                    pb[qt][ks2] = __builtin_bit_cast(bf16x8, pu);
                    lacc[qt] = mfma16(ones, pb[qt][ks2], lacc[qt]);
                }
            }
        }
        if (more) asm volatile("s_waitcnt vmcnt(6)" ::: "memory"); else asm volatile("s_waitcnt vmcnt(0)" ::: "memory");
        RAW_BARRIER();
        if (active) {
            __builtin_amdgcn_s_setprio(1);
#pragma unroll
            for (int ks2 = 0; ks2 < 2; ++ks2)
#pragma unroll
                for (int dt = 0; dt < 8; ++dt) {
                    const unsigned char* vr = Vs + (dt * 16 + fr) * 128 + (fq & 1) * 8;
                    const u32x2 v0 = *(const u32x2*)(vr + (((ks2 * 4 + (fq >> 1)) ^ fsw) * 16));
                    const u32x2 v1 = *(const u32x2*)(vr + (((ks2 * 4 + (fq >> 1) + 2) ^ fsw) * 16));
                    u32x4 vv; vv.x = v0.x; vv.y = v0.y; vv.z = v1.x; vv.w = v1.y;
                    const bf16x8 vf = __builtin_bit_cast(bf16x8, vv);
#pragma unroll
                    for (int qt = 0; qt < MLA_QT; ++qt) O[qt][dt] = mfma16(vf, pb[qt][ks2], O[qt][dt]);
                }
            __builtin_amdgcn_s_setprio(0);
        }
    }
#undef MLA_ISSUE_K
#undef MLA_ISSUE_V
#pragma unroll
    for (int qt = 0; qt < MLA_QT; ++qt) {
        const float lt_ = lacc[qt][0];
        const float il = lt_ > 0.f ? 1.f / lt_ : 0.f;
        const long row = (long)b * T + wq0 + qt * 16 + fr;
#pragma unroll
        for (int dt = 0; dt < 8; ++dt) st_bf16x4(obuf + row * OBLD + h * 128 + dt * 16 + fq * 4, O[qt][dt] * il);
    }
    RAW_BARRIER();
}

DEV void phase_mla(const Params& p, unsigned char* smem) {
    float negC;
    {
        const int lane = threadIdx.x & 63;
        const float* kn = p.in[IN_KV_K_NORM]; const float* qn = p.in[IN_B_Q_NORM];
        float gk = fmaxf(fmaxf(fabsf(kn[lane]), fabsf(kn[64 + lane])), fabsf(kn[128 + lane]));
        float gq = fmaxf(fmaxf(fabsf(qn[lane]), fabsf(qn[64 + lane])), fabsf(qn[128 + lane]));
        for (int o = 1; o < 64; o <<= 1) { gk = fmaxf(gk, __shfl_xor(gk, o)); gq = fmaxf(gq, __shfl_xor(gq, o)); }
        negC = -fminf(192.f * QSCALE_MLA * 1.02f * gk * gq + 0.5f, 60.f);
        negC = __uint_as_float(__builtin_amdgcn_readfirstlane(__float_as_uint(negC)));
    }
    const int nitems = 16 * (T / (64 * MLA_QT)), G = gridDim.x;
    for (int rr = 0; rr * G < nitems; ++rr) {
        const int idx = (rr & 1) ? (rr + 1) * G - 1 - (int)blockIdx.x : rr * G + (int)blockIdx.x;
        if (idx >= nitems) continue;
        mla_item(p, smem, idx & 15, (T / (64 * MLA_QT)) - 1 - (idx >> 4), negC);
    }
}


#define XB_TMO      128
#define XB_XCNT(j)  (256  + 64 * (j))
#define XB_XSUB(j)  (1280 + 64 * (j))
#define XB_XGEN(j)  (2304 + 64 * (j))
#define XB_TOP      3328
#define XB_TOPGEN   3392
#define XCD_BAR_WORDS 3456
#define XB_SPIN_CAP (1u << 20)
DEV unsigned xb_ld(unsigned* p)              { return __hip_atomic_load(p, __ATOMIC_RELAXED, __HIP_MEMORY_SCOPE_AGENT); }
DEV unsigned xb_add(unsigned* p, unsigned v) { return __hip_atomic_fetch_add(p, v, __ATOMIC_RELAXED, __HIP_MEMORY_SCOPE_AGENT); }
DEV unsigned xb_xcc_id() { return (unsigned)__builtin_amdgcn_s_getreg((3 << 11) | 20) & 0xFu; }
#define XB_SPIN(cond, bar) do { unsigned _sp = 0; while (cond) { __builtin_amdgcn_s_sleep(1); \
    if ((++_sp & 255u) == 0u) { if (xb_ld(&(bar)[XB_TMO])) break; if (_sp > XB_SPIN_CAP) { atomicAdd(&(bar)[XB_TMO], 1u); break; } } } } while (0)
struct XcdBarrier { unsigned* bar; unsigned x; volatile LAS unsigned* st; };
DEV XcdBarrier xcd_barrier_post(unsigned* bar, volatile LAS unsigned* st) {
    XcdBarrier b; b.bar = bar; b.x = xb_xcc_id(); b.st = st;
    if (threadIdx.x == 0) (void)xb_add(&bar[XB_XCNT(b.x)], 1u);
    return b;
}
DEV void xcd_barrier_complete(unsigned* bar, unsigned x, unsigned& nloc, unsigned& nx) {
    const unsigned G = gridDim.x * gridDim.y * gridDim.z;
    unsigned sum, cnt, mine, sp = 0u;
    for (;;) {
        sum = 0u; cnt = 0u; mine = 0u;
#pragma unroll
        for (unsigned j = 0; j < 16; ++j) { const unsigned c = xb_ld(&bar[XB_XCNT(j)]); sum += c; cnt += (c > 0u) ? 1u : 0u; mine = (j == x) ? c : mine; }
        if (sum == G) break;
        __builtin_amdgcn_s_sleep(1);
        if ((++sp & 255u) == 0u) { if (xb_ld(&bar[XB_TMO])) break; if (sp > XB_SPIN_CAP) { atomicAdd(&bar[XB_TMO], 1u); break; } }
    }
    nloc = mine > 0u ? mine : 1u; nx = cnt > 0u ? cnt : 1u;
}
DEV void xcd_barrier(const XcdBarrier& b) {
    asm volatile("s_waitcnt vmcnt(0)" ::: "memory");
    __syncthreads();
    if (threadIdx.x == 0) {
        unsigned* bar = b.bar;
        __builtin_amdgcn_s_waitcnt(0);
        unsigned nloc = b.st[0], nx = b.st[1];
        if (nloc == 0u) { xcd_barrier_complete(bar, b.x, nloc, nx); b.st[0] = nloc; b.st[1] = nx; }
        const unsigned old = xb_add(&bar[XB_XSUB(b.x)], 1u);
        const unsigned gen = old / nloc;
        if (old + 1u == (gen + 1u) * nloc) {
            __builtin_amdgcn_fence(__ATOMIC_RELEASE, "agent");
            asm volatile("s_waitcnt vmcnt(0)" ::: "memory");
            const unsigned og = xb_add(&bar[XB_TOP], 1u);
            const unsigned tg = og / nx;
            if (og + 1u == (tg + 1u) * nx) xb_add(&bar[XB_TOPGEN], 1u);
            else XB_SPIN(xb_ld(&bar[XB_TOPGEN]) == tg, bar);
            __builtin_amdgcn_fence(__ATOMIC_ACQUIRE, "agent");
            xb_add(&bar[XB_XGEN(b.x)], 1u);
            asm volatile("s_waitcnt vmcnt(0)" ::: "memory");
        } else {
            XB_SPIN(xb_ld(&bar[XB_XGEN(b.x)]) == gen, bar);
            __builtin_amdgcn_fence(__ATOMIC_ACQUIRE, "agent");
            asm volatile("s_waitcnt vmcnt(0)" ::: "memory");
        }
    }
    __syncthreads();
}

constexpr int N_PHASES = 15;

DEV void run_phase(const Params& p, int ph, unsigned char* smem) {
    unsigned char* ws = p.ws;
    float* SS = (float*)(ws + OFF_SS);
    const int G = gridDim.x, bid = blockIdx.x;
#ifdef PHASE_MASK
    if (!((PHASE_MASK >> ph) & 1)) return;
#endif
    switch (ph) {
    case 0: phase_prologue(p, smem); break;
    case 1: {
        EpiInProj e{SS, p.in[IN_A_Q_NORM], p.in[IN_A_KSLC_NORM], p.in[IN_A_KWIN_NORM], (bf16_t*)(ws + OFF_PROJ), (bf16_t*)(ws + OFF_VSLT), (bf16_t*)(ws + OFF_VWT), (float*)(ws + OFF_GATES), smem};
        for (int tl = bid; tl < 128 * 21; tl += G) gemm_tile(RowLin{XBLD}, (const bf16_t*)(ws + OFF_XB), 64, (const bf16_t*)(ws + OFF_WT_IN), 1024, tl / 21, tl % 21, e, smem);
    } break;
    case 2: {
        trans_range(p, NJOBS_L0, p.njobs, G > 256 ? 128 : 0, (float*)smem);
        for (int tl = bid; tl < 128; tl += G) {
            const int which = tl >> 6, r = tl & 63;
            EpiCmp1 e{(const float*)(ws + OFF_B1) + which * 256, (bf16_t*)(ws + OFF_HID) + (size_t)which * 4096 * 256};
            gemm_tile(RowCmp{which ? 1280 : 1024}, (const bf16_t*)(ws + OFF_PROJ), 2048, (const bf16_t*)(ws + (which ? OFF_WT_C1V : OFF_WT_C1K)), 2048, r >> 1, r & 1, e, smem);
        }
    } break;
    case 3: {
        for (int tl = bid; tl < 64; tl += G) {
            const int which = tl >> 5, r = tl & 31;
            EpiCmp2 e{which, p.in[IN_A_KCMP_NORM], (bf16_t*)(ws + OFF_KCMP), (bf16_t*)(ws + OFF_VCMPT)};
            gemm_tile(RowLin{256}, (const bf16_t*)(ws + OFF_HID) + (size_t)which * 4096 * 256, 64, (const bf16_t*)(ws + (which ? OFF_WT_C2V : OFF_WT_C2K)), 256, r, 0, e, smem);
        }
    } break;
    case 4: phase_nsa(p, smem); break;
    case 5: case 12: {
        const bool l0 = ph == 5;
        EpiResid e{l0 ? p.in[IN_X] : p.out, p.out, (bf16_t*)(ws + OFF_XB), SS + (l0 ? 1 : 3) * M};
        const bf16_t* wt = (const bf16_t*)(ws + (l0 ? OFF_WT_OUT0 : OFF_WT_OUT1));
        for (int tl = bid; tl < 128 * 8; tl += G) gemm_tile(RowLin{OBLD}, (const bf16_t*)(ws + OFF_OBUF), 64, wt, 1024, tl >> 3, tl & 7, e, smem);
    } break;
    case 6: case 13: {
        const bool l0 = ph == 6;
        EpiGateUp e{SS + (l0 ? 1 : 3) * M, (bf16_t*)(ws + OFF_HBUF)};
        const bf16_t* wt = (const bf16_t*)(ws + (l0 ? OFF_WT_GU0 : OFF_WT_GU1));
        for (int tl = bid; tl < 128 * 44; tl += G) gemm_tile(RowLin{XBLD}, (const bf16_t*)(ws + OFF_XB), 64, wt, 1024, tl / 44, tl % 44, e, smem);
    } break;
    case 7: case 14: {
        const bool l0 = ph == 7;
        EpiResid e{p.out, p.out, (bf16_t*)(ws + OFF_XB), l0 ? SS + 2 * M : (float*)nullptr};
        const bf16_t* wt = (const bf16_t*)(ws + (l0 ? OFF_WT_DN0 : OFF_WT_DN1));
        for (int tl = bid; tl < 128 * 8; tl += G) gemm_tile(RowLin{2816}, (const bf16_t*)(ws + OFF_HBUF), 64, wt, 2816, tl >> 3, tl & 7, e, smem);
    } break;
    case 8: {
        EpiKvqa e{SS + 2 * M, (bf16_t*)(ws + OFF_KVA), SS + 4 * M, SS + 5 * M};
        for (int tl = bid; tl < 128 * 6; tl += G) gemm_tile(RowLin{XBLD}, (const bf16_t*)(ws + OFF_XB), 64, (const bf16_t*)(ws + OFF_WT_KVQA), 1024, tl / 6, tl % 6, e, smem);
    } break;
    case 9: {
        EpiKvb ek{SS + 4 * M, (bf16_t*)(ws + OFF_K), (bf16_t*)(ws + OFF_VT), smem};
        EpiQb eq{SS + 5 * M, (bf16_t*)(ws + OFF_Q)};
        for (int tl = bid; tl < 128 * 16 + 128 * 12; tl += G) {
            if (tl < 2048) gemm_tile(RowLin{768}, (const bf16_t*)(ws + OFF_KVA), 64, (const bf16_t*)(ws + OFF_WT_KVB), 256, tl >> 4, tl & 15, ek, smem);
            else { const int u = tl - 2048; gemm_tile(RowLin{768}, (const bf16_t*)(ws + OFF_KVA) + 320, 64, (const bf16_t*)(ws + OFF_WT_QB), 384, u / 12, u % 12, eq, smem); }
        }
    } break;
    case 10: phase_finish(p); break;
    case 11: phase_mla(p, smem); break;
    default: break;
    }
}

__global__ void __launch_bounds__(256, 2) fwd_kernel(Params p) {
    __shared__ __attribute__((aligned(16))) unsigned char smem[65536];
#if COOP
    cg::grid_group grid = cg::this_grid();
    __shared__ uint4 xb_words;
    if (threadIdx.x == 0) xb_words = make_uint4(0u, 0u, 0u, 0u);
    __syncthreads();
    const XcdBarrier xb = xcd_barrier_post((unsigned*)(p.ws + OFF_BAR), (volatile LAS unsigned*)&xb_words);
    if (p.ph0 != 0) grid.sync();
    run_phase(p, 0, smem); xcd_barrier(xb);
    run_phase(p, 1, smem); xcd_barrier(xb);
    run_phase(p, 2, smem); xcd_barrier(xb);
    run_phase(p, 3, smem); xcd_barrier(xb);
    run_phase(p, 4, smem); xcd_barrier(xb);
    run_phase(p, 5, smem); xcd_barrier(xb);
    run_phase(p, 6, smem); xcd_barrier(xb);
    run_phase(p, 7, smem); xcd_barrier(xb);
    run_phase(p, 8, smem); xcd_barrier(xb);
    run_phase(p, 9, smem); xcd_barrier(xb);
    run_phase(p, 10, smem); xcd_barrier(xb);
    run_phase(p, 11, smem); xcd_barrier(xb);
    run_phase(p, 12, smem); xcd_barrier(xb);
    run_phase(p, 13, smem); xcd_barrier(xb);
    run_phase(p, 14, smem);
#else
    run_phase(p, p.ph0, smem);
#endif
}

static void add_job(Params& p, const float* src, const float* gain, size_t dst_off, int dst_row0, int K, int ldsrc, int nvalid, int nchunks, int mode) {
    TJob& j = p.jobs[p.njobs++];
    j.src = src; j.gain = gain; j.dst = (bf16_t*)(p.ws + dst_off) + (size_t)dst_row0 * (K + 64); j.ldd = K + 64; j.K = K; j.ldsrc = ldsrc; j.nvalid = nvalid; j.nchunks = nchunks; j.mode = mode; j.tile0 = p.ntrans;
    p.ntrans += (K / 64) * ((nchunks + 3) / 4);
}

extern "C" void kernel_launch(void* const* d_in, const int* in_sizes, int n_in, void* d_out, int out_size, void* d_ws, size_t ws_size, hipStream_t stream) {
    Params p;
    memset(&p, 0, sizeof(p));
    for (int i = 0; i < N_IN; ++i) p.in[i] = (const float*)d_in[i];
    p.out = (float*)d_out; p.ws = (unsigned char*)d_ws;
    if (ws_size < WS_NEED) { fprintf(stderr, "workspace too small: %zu < %zu\n", ws_size, (size_t)WS_NEED); return; }
    const float* ffn_norm = p.in[IN_FFN_NORM]; const float* wgu = p.in[IN_FFN_W_GU]; const float* wdn = p.in[IN_FFN_W_DN];
    add_job(p, p.in[IN_A_W_IN], p.in[IN_A_ATTN_NORM], OFF_WT_IN, 0, 1024, 2608, 2608, 84, 0);
    add_job(p, p.in[IN_K_W1], nullptr, OFF_WT_C1K, 0, 2048, 256, 256, 8, 0);
    add_job(p, p.in[IN_V_W1], nullptr, OFF_WT_C1V, 0, 2048, 256, 256, 8, 0);
    add_job(p, p.in[IN_K_W2], nullptr, OFF_WT_C2K, 0, 256, 64, 64, 4, 0);
    add_job(p, p.in[IN_V_W2], nullptr, OFF_WT_C2V, 0, 256, 64, 64, 4, 0);
    add_job(p, p.in[IN_A_W_OUT], nullptr, OFF_WT_OUT0, 0, 1024, 1024, 1024, 32, 0);
    add_job(p, wgu, ffn_norm, OFF_WT_GU0, 0, 1024, 5632, 5632, 176, 1);
    add_job(p, wdn, nullptr, OFF_WT_DN0, 0, 2816, 1024, 1024, 32, 0);
    add_job(p, p.in[IN_KV_W_A], p.in[IN_KV_NORM], OFF_WT_KVQA, 0, 1024, 320, 320, 10, 0);
    add_job(p, p.in[IN_B_W_Q_A], p.in[IN_B_ATTN_NORM], OFF_WT_KVQA, 320, 1024, 384, 384, 14, 0);
    add_job(p, p.in[IN_KV_W_B], p.in[IN_KV_C_NORM], OFF_WT_KVB, 0, 256, 2048, 2048, 64, 0);
    add_job(p, p.in[IN_B_W_Q_B], p.in[IN_B_Q_A_NORM], OFF_WT_QB, 0, 384, 1536, 1536, 48, 0);
    add_job(p, p.in[IN_B_W_OUT], nullptr, OFF_WT_OUT1, 0, 1024, 1024, 1024, 32, 0);
    add_job(p, wgu + (size_t)1024 * 5632, ffn_norm + 1024, OFF_WT_GU1, 0, 1024, 5632, 5632, 176, 1);
    add_job(p, wdn + (size_t)2816 * 1024, nullptr, OFF_WT_DN1, 0, 2816, 1024, 1024, 32, 0);
    static int grid = 0;
    if (!grid) {
        int dev = 0, cus = 0, per_cu = 0;
        hipGetDevice(&dev);
        hipDeviceGetAttribute(&cus, hipDeviceAttributeMultiprocessorCount, dev);
        hipOccupancyMaxActiveBlocksPerMultiprocessor(&per_cu, fwd_kernel, 256, 0);
        if (per_cu > 2) per_cu = 2;
        if (per_cu < 1) per_cu = 1;
        if (cus <= 0) cus = 256;
        grid = cus * per_cu;
    }
#if COOP
    p.ph0 = 0; p.ph1 = N_PHASES;
    hipMemsetAsync(p.ws + OFF_BAR, 0, XCD_BAR_WORDS * 4, stream);
    void* args[] = {&p};
    hipError_t e = hipLaunchCooperativeKernel((void*)fwd_kernel, dim3(grid), dim3(256), args, 0, stream);
    if (e != hipSuccess) fprintf(stderr, "cooperative launch failed: %s\n", hipGetErrorString(e));
#else
    for (int ph = 0; ph < N_PHASES; ++ph) {
        p.ph0 = ph; p.ph1 = ph + 1;
#ifdef DUP_PHASE
        if (ph == DUP_PHASE) { p.abl = DUP_ABL; for (int rep = 0; rep < DUP_REPS; ++rep) fwd_kernel<<<grid, 256, 0, stream>>>(p); p.abl = 0; }
#endif
        fwd_kernel<<<grid, 256, 0, stream>>>(p);
    }
#endif
}
```
